# Optimizing an MI355X kernel written in HIP

```python
import jax
import jax.numpy as jnp
from jax import lax
import numpy as np

D_MODEL = 1024
BATCH = 8
SEQ = 4096
DEPTH = 2

N_MIXERS = 2
N_RWKV_LAYERS = (DEPTH + 1) // 2
N_NSA_LAYERS = DEPTH // 2
HEAD_DIM = 64
N_HEADS = D_MODEL // HEAD_DIM
NORM_EPS = 1e-6
N_SHIFT_MIX = 6
N_RWKV_PROJ = 4
DECAY_LORA = 64
ICLR_LORA = 64
LN_X_EPS = 64e-5
N_KV_GROUPS = 4
HEADS_PER_GROUP = N_HEADS // N_KV_GROUPS
KV_WIDTH = N_KV_GROUPS * HEAD_DIM
N_BRANCHES = 3
CMP_BLOCK = 32
CMP_STRIDE = 16
CMP_HIDDEN = 256
SLC_BLOCK = 64
SLC_TOPK = 16
N_LOCAL_BLOCKS = 2
WINDOW = 512
Q_BLOCK = 32
FORCE_BONUS = 1e4
NEG_INF = -1e30
NSA_IN_WIDTH = D_MODEL + 6 * KV_WIDTH + D_MODEL + N_BRANCHES * N_HEADS

kernel_name = "hybrid_rwkv7_nsa_interleaved"


def rms_norm(x, g, eps=NORM_EPS):
    xf = x.astype(jnp.float32)
    y = xf * lax.rsqrt(jnp.mean(xf * xf, axis=-1, keepdims=True) + eps)
    return (y * g.astype(jnp.float32)).astype(x.dtype)


def masked_softmax(s, mask):
    s = jnp.where(mask, s.astype(jnp.float32), NEG_INF)
    return jnp.where(mask, jax.nn.softmax(s, axis=-1), 0.0)


def wkv7_scan(r, w, k, v, kk, a):
    B, T, H, N = r.shape

    def step(S, inp):
        r_t, w_t, k_t, v_t, kk_t, a_t = inp
        sa = jnp.einsum('bhvk,bhk->bhv', S, -kk_t)
        S = (S * w_t[:, :, None, :]
             + sa[..., None] * (kk_t * a_t)[:, :, None, :]
             + v_t[..., None] * k_t[:, :, None, :])
        return S, jnp.einsum('bhvk,bhk->bhv', S, r_t)

    xs = tuple(jnp.moveaxis(u, 1, 0) for u in (r, w, k, v, kk, a))
    S0 = jnp.zeros((B, H, N, N), jnp.float32)
    _, o = lax.scan(step, S0, xs)
    return jnp.moveaxis(o, 0, 1)


def rwkv7_mixer(h, mu, w_in, w0, w1, w2, a0, a1, a2, k_k, k_a, r_k, lnx_g, lnx_b, w_out):
    B, T, D = h.shape
    H, N = N_HEADS, HEAD_DIM
    f32 = jnp.float32
    dh = jnp.pad(h, ((0, 0), (1, 0), (0, 0)))[:, :-1] - h
    xm = h[None] + dh[None] * mu[:, None, None, :]
    proj = jnp.einsum('cbtd,dcf->cbtf', xm[:N_RWKV_PROJ], w_in.reshape(D, N_RWKV_PROJ, D))
    r, k, v, z = proj[0], proj[1], proj[2], proj[3]
    xw, xa = xm[4], xm[5]
    w_log = -jax.nn.softplus(-(w0 + jnp.tanh(xw @ w1) @ w2).astype(f32)) - 0.5
    decay = jnp.exp(-jnp.exp(w_log))
    a = jax.nn.sigmoid((a0 + (xa @ a1) @ a2).astype(f32))
    heads = lambda u: u.astype(f32).reshape(B, T, H, N)
    r, k, v, decay, a = heads(r), heads(k), heads(v), heads(decay), heads(a)
    kk = k * k_k.astype(f32).reshape(H, N)
    kk = kk / jnp.maximum(jnp.sqrt(jnp.sum(kk * kk, axis=-1, keepdims=True)), 1e-12)
    k = k * (1.0 + (a - 1.0) * k_a.astype(f32).reshape(H, N))
    o = wkv7_scan(r, decay, k, v, kk, a)
    mean = jnp.mean(o, axis=-1, keepdims=True)
    var = jnp.mean(jnp.square(o - mean), axis=-1, keepdims=True)
    o = ((o - mean) * lax.rsqrt(var + LN_X_EPS) * lnx_g.astype(f32).reshape(H, N)
         + lnx_b.astype(f32).reshape(H, N))
    o = o + jnp.sum(r * k * r_k.astype(f32), axis=-1, keepdims=True) * v
    y = o.reshape(B, T, D).astype(h.dtype) * jax.nn.silu(z)
    return y @ w_out


def compress_blocks(u, pe, w1, b1, w2):
    T = u.shape[1]
    n_cmp = (T - CMP_BLOCK) // CMP_STRIDE + 1
    idx = jnp.arange(n_cmp)[:, None] * CMP_STRIDE + jnp.arange(CMP_BLOCK)[None, :]
    blocks = u[:, idx] + pe[None, None, :, None, :]
    hid = jax.nn.gelu(jnp.einsum('bnlgd,ldf->bngf', blocks,
                                 w1.reshape(CMP_BLOCK, HEAD_DIM, CMP_HIDDEN)) + b1)
    return jnp.einsum('bngf,fd->bngd', hid, w2)


def nsa_mixer(h, w_in, q_gain, k_gain, cmp_pe, cmp_w1, cmp_b1, cmp_w2, w_out):
    B, T, D = h.shape
    G, HG, N = N_KV_GROUPS, HEADS_PER_GROUP, HEAD_DIM
    f32 = jnp.float32
    proj = h @ w_in
    sizes = [D] + [KV_WIDTH] * 6 + [D, N_BRANCHES * N_HEADS]
    offs = np.cumsum(sizes)[:-1].tolist()
    q, kc_raw, vc_raw, ks, vs, kw, vw, z, gate = jnp.split(proj, offs, axis=-1)
    q = rms_norm(q.reshape(B, T, G, HG, N), q_gain)
    kv = lambda u: u.reshape(B, T, G, N)
    kc = rms_norm(compress_blocks(kv(kc_raw), cmp_pe[0], cmp_w1[0], cmp_b1[0], cmp_w2[0]), k_gain[0])
    vc = compress_blocks(kv(vc_raw), cmp_pe[1], cmp_w1[1], cmp_b1[1], cmp_w2[1])
    ks = rms_norm(kv(ks), k_gain[1])
    vs = kv(vs)
    kw = rms_norm(kv(kw), k_gain[2])
    vw = kv(vw)

    n_cmp = kc.shape[1]
    n_slc = T // SLC_BLOCK
    n_top = min(SLC_TOPK, n_slc)
    n_qb = T // Q_BLOCK
    scale = HEAD_DIM ** -0.5
    cmp_start = jnp.arange(n_cmp) * CMP_STRIDE
    cmp_end = cmp_start + CMP_BLOCK - 1
    slc_start = jnp.arange(n_slc) * SLC_BLOCK
    overlap = ((cmp_start[:, None] < slc_start[None, :] + SLC_BLOCK)
               & (cmp_end[:, None] >= slc_start[None, :])).astype(f32)
    ks_blk = jnp.moveaxis(ks.reshape(B, n_slc, SLC_BLOCK, G, N), 3, 1)
    vs_blk = jnp.moveaxis(vs.reshape(B, n_slc, SLC_BLOCK, G, N), 3, 1)
    kw_pad = jnp.pad(kw, ((0, 0), (WINDOW, 0), (0, 0), (0, 0)))
    vw_pad = jnp.pad(vw, ((0, 0), (WINDOW, 0), (0, 0), (0, 0)))
    b_ix = jnp.arange(B)[:, None, None, None]
    g_ix = jnp.arange(G)[None, :, None, None]
    blk_ids = jnp.arange(n_slc)

    def query_block(args):
        qb, q_blk, g_blk = args
        t = qb * Q_BLOCK + jnp.arange(Q_BLOCK)
        s = jnp.einsum('bqghd,bngd->bghqn', q_blk, kc).astype(f32) * scale
        p_cmp = masked_softmax(s, cmp_end[None, :] <= t[:, None])
        o_cmp = jnp.einsum('bghqn,bngd->bqghd', p_cmp.astype(vc.dtype), vc)
        imp = jnp.einsum('bghqn,nj->bgqj', p_cmp, overlap)
        dist = (t // SLC_BLOCK)[:, None] - blk_ids[None, :]
        forced = (blk_ids[None, :] == 0) | ((dist >= 0) & (dist < N_LOCAL_BLOCKS))
        score = jnp.where(dist >= 0, imp + jnp.where(forced, FORCE_BONUS, 0.0), -jnp.inf)
        _, sel = lax.top_k(score, n_top)
        k_sel = ks_blk[b_ix, g_ix, sel]
        v_sel = vs_blk[b_ix, g_ix, sel].reshape(B, G, Q_BLOCK, n_top * SLC_BLOCK, N)
        tok = sel[..., None] * SLC_BLOCK + jnp.arange(SLC_BLOCK)
        sel_mask = (tok <= t[None, None, :, None, None]).reshape(B, G, 1, Q_BLOCK, n_top * SLC_BLOCK)
        s = jnp.einsum('bqghd,bgqnsd->bghqns', q_blk, k_sel).astype(f32) * scale
        p = masked_softmax(s.reshape(B, G, HG, Q_BLOCK, n_top * SLC_BLOCK), sel_mask)
        o_slc = jnp.einsum('bghqm,bgqmd->bqghd', p.astype(v_sel.dtype), v_sel)
        start = qb * Q_BLOCK
        k_win = lax.dynamic_slice_in_dim(kw_pad, start, Q_BLOCK + WINDOW, axis=1)
        v_win = lax.dynamic_slice_in_dim(vw_pad, start, Q_BLOCK + WINDOW, axis=1)
        kpos = start - WINDOW + jnp.arange(Q_BLOCK + WINDOW)
        lag = t[:, None] - kpos[None, :]
        win_mask = (lag >= 0) & (lag < WINDOW) & (kpos[None, :] >= 0)
        s = jnp.einsum('bqghd,bkgd->bghqk', q_blk, k_win).astype(f32) * scale
        p = masked_softmax(s, win_mask)
        o_win = jnp.einsum('bghqk,bkgd->bqghd', p.astype(v_win.dtype), v_win)
        g = jax.nn.sigmoid(g_blk.astype(f32))[..., None]
        o = g[:, :, 0] * o_cmp + g[:, :, 1] * o_slc + g[:, :, 2] * o_win
        return o.astype(q_blk.dtype)

    q_blocks = jnp.moveaxis(q.reshape(B, n_qb, Q_BLOCK, G, HG, N), 1, 0)
    g_blocks = jnp.moveaxis(gate.reshape(B, n_qb, Q_BLOCK, N_BRANCHES, G, HG), 1, 0)
    o = lax.map(query_block, (jnp.arange(n_qb), q_blocks, g_blocks))
    o = jnp.moveaxis(o, 0, 1).reshape(B, T, D)
    y = o * jax.nn.silu(z)
    return y @ w_out


def setup_inputs(seed: int = 0) -> dict:
    key = jax.random.key(seed)
    keys = iter(jax.random.split(key, 32))
    nrm = lambda shape, scale: jax.random.normal(next(keys), shape, jnp.float32) * scale
    D, H, N = D_MODEL, N_HEADS, HEAD_DIM
    Lr, Ln = N_RWKV_LAYERS, N_NSA_LAYERS
    return {
        "x": nrm((BATCH, SEQ, D), 1.0),
        "norm_g": 1.0 + nrm((DEPTH, D), 0.02),
        "rwkv_mu": jax.random.uniform(next(keys), (Lr, N_SHIFT_MIX, D), jnp.float32),
        "rwkv_w_in": nrm((Lr, D, N_RWKV_PROJ * D), D ** -0.5),
        "rwkv_w0": nrm((Lr, D), 0.5),
        "rwkv_w1": nrm((Lr, D, DECAY_LORA), D ** -0.5),
        "rwkv_w2": nrm((Lr, DECAY_LORA, D), 0.5 * DECAY_LORA ** -0.5),
        "rwkv_a0": nrm((Lr, D), 0.1),
        "rwkv_a1": nrm((Lr, D, ICLR_LORA), D ** -0.5),
        "rwkv_a2": nrm((Lr, ICLR_LORA, D), 0.5 * ICLR_LORA ** -0.5),
        "rwkv_k_k": 0.85 + nrm((Lr, D), 0.02),
        "rwkv_k_a": 1.0 + nrm((Lr, D), 0.02),
        "rwkv_r_k": nrm((Lr, H, N), 0.1),
        "rwkv_lnx_g": 1.0 + nrm((Lr, D), 0.02),
        "rwkv_lnx_b": nrm((Lr, D), 0.02),
        "rwkv_w_out": nrm((Lr, D, D), D ** -0.5),
        "nsa_w_in": nrm((Ln, D, NSA_IN_WIDTH), D ** -0.5),
        "nsa_q_gain": 1.0 + nrm((Ln, N), 0.02),
        "nsa_k_gain": 1.0 + nrm((Ln, N_BRANCHES, N), 0.02),
        "nsa_cmp_pe": nrm((Ln, 2, CMP_BLOCK, N), 0.1),
        "nsa_cmp_w1": nrm((Ln, 2, CMP_BLOCK * N, CMP_HIDDEN), (CMP_BLOCK * N) ** -0.5),
        "nsa_cmp_b1": nrm((Ln, 2, CMP_HIDDEN), 0.02),
        "nsa_cmp_w2": nrm((Ln, 2, CMP_HIDDEN, N), CMP_HIDDEN ** -0.5),
        "nsa_w_out": nrm((Ln, D, D), D ** -0.5),
    }


def reference(x, norm_g, rwkv_mu, rwkv_w_in, rwkv_w0, rwkv_w1, rwkv_w2, rwkv_a0, rwkv_a1,
              rwkv_a2, rwkv_k_k, rwkv_k_a, rwkv_r_k, rwkv_lnx_g, rwkv_lnx_b, rwkv_w_out,
              nsa_w_in, nsa_q_gain, nsa_k_gain, nsa_cmp_pe, nsa_cmp_w1, nsa_cmp_b1, nsa_cmp_w2,
              nsa_w_out):
    for i in range(DEPTH):
        h = rms_norm(x, norm_g[i])
        j = i // N_MIXERS
        if i % N_MIXERS == 0:
            y = rwkv7_mixer(h, rwkv_mu[j], rwkv_w_in[j], rwkv_w0[j], rwkv_w1[j], rwkv_w2[j],
                            rwkv_a0[j], rwkv_a1[j], rwkv_a2[j], rwkv_k_k[j], rwkv_k_a[j],
                            rwkv_r_k[j], rwkv_lnx_g[j], rwkv_lnx_b[j], rwkv_w_out[j])
        else:
            y = nsa_mixer(h, nsa_w_in[j], nsa_q_gain[j], nsa_k_gain[j], nsa_cmp_pe[j],
                          nsa_cmp_w1[j], nsa_cmp_b1[j], nsa_cmp_w2[j], nsa_w_out[j])
        x = x + y
    return x
```

```cpp
#include <hip/hip_runtime.h>
#include <hip/hip_cooperative_groups.h>
#include <cstdio>
#include <cstdint>
namespace cg = cooperative_groups;

#ifndef MULTI_LAUNCH
#define MULTI_LAUNCH 0
#endif

#define DEVI __device__ __forceinline__
typedef unsigned short u16;
typedef unsigned long long u64;
typedef short bf16x8 __attribute__((ext_vector_type(8)));
typedef float f32x16 __attribute__((ext_vector_type(16)));
typedef float f32x4 __attribute__((ext_vector_type(4)));
typedef unsigned u32x4 __attribute__((ext_vector_type(4)));
typedef unsigned u32x2 __attribute__((ext_vector_type(2)));
typedef _Float16 h8 __attribute__((ext_vector_type(8)));
typedef _Float16 h4 __attribute__((ext_vector_type(4)));

constexpr int NT = 32768, SEQ = 4096, DM = 1024;
constexpr size_t MiB = 1u << 20;
constexpr size_t WT_IN = 0, WT_L1 = 8 * MiB, WT_W2 = 8 * MiB + 512 * 1024, WT_A2 = WT_W2 + 128 * 1024, WT_OUT = 9 * MiB,
                 WT_NIN = 11 * MiB, WT_C1 = 19 * MiB, WT_C2 = 21 * MiB, WT_NOUT = 22 * MiB;
constexpr size_t OFF_H = 32 * MiB, OFF_R = 96 * MiB, OFF_K = 160 * MiB, OFF_V = 224 * MiB, OFF_Z = 288 * MiB, OFF_HID = 352 * MiB,
                 OFF_Y = 360 * MiB, OFF_O = 424 * MiB;
constexpr size_t OFF_Q = OFF_R, OFF_ZS = OFF_Z, OFF_KCR = 160 * MiB, OFF_VCR = 176 * MiB, OFF_KS = 192 * MiB, OFF_VST = 208 * MiB,
                 OFF_KW = 224 * MiB, OFF_VWT = 240 * MiB, OFF_G = OFF_HID, OFF_HIDC = 424 * MiB, OFF_KC = 432 * MiB, OFF_VCT = 433 * MiB;

constexpr size_t OFF_BAR = 500 * MiB;
DEVI unsigned xcc_id_() { return (unsigned)__builtin_amdgcn_s_getreg((3 << 11) | 20) & 0xFu; }
struct Params {
  const float *x, *norm_g, *mu, *w_in, *w0, *w1, *w2, *a0, *a1, *a2, *k_k, *k_a, *r_k, *lnx_g, *lnx_b, *w_out;
  const float *n_w_in, *q_gain, *k_gain, *cmp_pe, *cmp_w1, *cmp_b1, *cmp_w2, *n_w_out;
  float* out; char* ws;
};

typedef __bf16 bf2_t __attribute__((ext_vector_type(2)));
typedef float f32x2 __attribute__((ext_vector_type(2)));
DEVI unsigned cvt_pk_bf16(float lo, float hi) { f32x2 v = {lo, hi}; bf2_t r = __builtin_convertvector(v, bf2_t); return __builtin_bit_cast(unsigned, r); }
DEVI float bflo(unsigned u) { return __uint_as_float(u << 16); }
DEVI float bfhi(unsigned u) { return __uint_as_float(u & 0xffff0000u); }
DEVI float sigmoidf_(float x) { return __builtin_amdgcn_rcpf(1.f + __expf(-x)); }
DEVI float siluf_(float x) { return x * __builtin_amdgcn_rcpf(1.f + __expf(-x)); }
DEVI float tanhf_(float x) { float e = __expf(-2.f * fabsf(x)); float t = (1.f - e) * __builtin_amdgcn_rcpf(1.f + e); return x < 0 ? -t : t; }
template <int CTRL> DEVI float dppf(float x) { return __builtin_bit_cast(float, __builtin_amdgcn_mov_dpp(__builtin_bit_cast(int, x), CTRL, 0xf, 0xf, true)); }
DEVI float allred16(float x) { x += dppf<0xB1>(x); x += dppf<0x4E>(x); x += dppf<0x141>(x); x += dppf<0x140>(x); return x; }
DEVI float quadsum(float x) { x += dppf<0xB1>(x); x += dppf<0x4E>(x); return x; }
DEVI int lds_off(int row, int c) { return row * 128 + ((c ^ ((row >> 1) & 7)) << 4); }

DEVI void cvt_job(char* lds, const float* __restrict__ src, int K, int N, int Npad, u16* __restrict__ dst, int ldd) {
  float* t = (float*)lds;
  const int tid = threadIdx.x;
  const int tk = K >> 6, tn = Npad >> 6;
  for (int tile = blockIdx.x; tile < tk * tn; tile += gridDim.x) {
    const int k0 = (tile % tk) << 6, n0 = (tile / tk) << 6;
#pragma unroll
    for (int i = 0; i < 16; ++i) {
      const int k = i * 4 + (tid >> 6), n = tid & 63;
      t[k * 65 + n] = (n0 + n < N) ? src[(size_t)(k0 + k) * N + n0 + n] : 0.f;
    }
    __syncthreads();
#pragma unroll
    for (int i = 0; i < 8; ++i) {
      const int n = i * 8 + (tid >> 5), kk = (tid & 31) * 2;
      *(unsigned*)(dst + (size_t)(n0 + n) * ldd + k0 + kk) = cvt_pk_bf16(t[kk * 65 + n], t[(kk + 1) * 65 + n]);
    }
    __syncthreads();
  }
}
DEVI void zero_job(u16* dst, int rows, int cols, int ldd) {
  const int cpr = cols >> 3;
  for (int i = blockIdx.x * 256 + threadIdx.x; i < rows * cpr; i += gridDim.x * 256) {
    const int r = i / cpr, c = i - r * cpr;
    *(u32x4*)(dst + (size_t)r * ldd + c * 8) = (u32x4){0, 0, 0, 0};
  }
}
DEVI void rmsnorm_phase(const float* __restrict__ X, const float* __restrict__ g, u16* __restrict__ H) {
  const int lane = threadIdx.x & 63, gw = blockIdx.x * 4 + (threadIdx.x >> 6), nw = gridDim.x * 4;
  f32x4 gv[4];
#pragma unroll
  for (int i = 0; i < 4; ++i) gv[i] = *(const f32x4*)(g + i * 256 + lane * 4);
  for (int row = gw; row < NT; row += nw) {
    f32x4 v[4]; float ss = 0.f;
#pragma unroll
    for (int i = 0; i < 4; ++i) { v[i] = *(const f32x4*)(X + (size_t)row * 1024 + i * 256 + lane * 4); ss += v[i][0] * v[i][0] + v[i][1] * v[i][1] + v[i][2] * v[i][2] + v[i][3] * v[i][3]; }
#pragma unroll
    for (int o = 1; o < 64; o <<= 1) ss += __shfl_xor(ss, o);
    const float rinv = rsqrtf(ss * (1.f / 1024.f) + 1e-6f);
#pragma unroll
    for (int i = 0; i < 4; ++i) {
      u32x2 w; w.x = cvt_pk_bf16(v[i][0] * rinv * gv[i][0], v[i][1] * rinv * gv[i][1]); w.y = cvt_pk_bf16(v[i][2] * rinv * gv[i][2], v[i][3] * rinv * gv[i][3]);
      *(u32x2*)(H + (size_t)row * 1024 + i * 256 + lane * 4) = w;
    }
  }
}

struct ALPlain {
  static constexpr int DEPTH = 2;
  const u16* A; int lda;
  DEVI void setup(int, int) {}
  static DEVI int row(int lr, int i) { return lr + 32 * i; }
  DEVI void load(u32x4 (&r)[4], int row0, int kc) const {
#pragma unroll
    for (int i = 0; i < 4; ++i) r[i] = *(const u32x4*)(A + (size_t)(row0 + 32 * i) * lda + kc);
  }
};
struct ALMix {
  static constexpr int DEPTH = 2;
  const u16* H; const float* mu; int mode; int c;
  DEVI void setup(int, int tn) { c = mode == 1 ? 4 + tn : (tn >> 3); }
  static DEVI int row(int lr, int i) { return lr * 4 + i; }
  DEVI void load(u32x4 (&r)[4], int row0, int kc) const {
    const int kk = kc; const float* m = mu + c * 1024;
    const f32x4 m0 = *(const f32x4*)(m + kk), m1 = *(const f32x4*)(m + kk + 4);
    const int lr = row0 & 31, rowb = (row0 - lr) + lr * 4;
    u32x4 hc[4];
#pragma unroll
    for (int i = 0; i < 4; ++i) hc[i] = *(const u32x4*)(H + (size_t)(rowb + i) * 1024 + kk);
    u32x4 hp = (u32x4){0, 0, 0, 0};
    if (rowb & (SEQ - 1)) hp = *(const u32x4*)(H + (size_t)(rowb - 1) * 1024 + kk);
#pragma unroll
    for (int i = 0; i < 4; ++i) {
      const u32x4 pv = i == 0 ? hp : hc[i > 0 ? i - 1 : 0];
      u32x4 o;
#pragma unroll
      for (int e = 0; e < 4; ++e) {
        const f32x2 c2 = {bflo(hc[i][e]), bfhi(hc[i][e])}, p2 = {bflo(pv[e]), bfhi(pv[e])};
        const f32x2 mm = {e < 2 ? m0[2 * e] : m1[2 * e - 4], e < 2 ? m0[2 * e + 1] : m1[2 * e - 3]};
        const f32x2 o2 = (p2 - c2) * mm + c2;
        o[e] = cvt_pk_bf16(o2.x, o2.y);
      }
      r[i] = o;
    }
  }
};
struct ALCmp {
  static constexpr int DEPTH = 2;
  const u16* rawk; const u16* rawv; const float* pe0; const u16* raw; const float* pe;
  DEVI void setup(int, int tn) { raw = (tn >> 1) ? rawv : rawk; pe = pe0 + (tn >> 1) * 2048; }
  static DEVI int row(int lr, int i) { return lr + 32 * i; }
  DEVI void load(u32x4 (&r)[4], int row0, int kc) const {
    const f32x4 p0 = *(const f32x4*)(pe + kc), p1 = *(const f32x4*)(pe + kc + 4);
#pragma unroll
    for (int i = 0; i < 4; ++i) {
      int row = row0 + 32 * i; row = row > 8159 ? 8159 : row;
      const int bg = row / 255, n = row - bg * 255;
      const u32x4 v = *(const u32x4*)(raw + ((size_t)bg * SEQ + n * 16) * 64 + kc);
      u32x4 o;
      o[0] = cvt_pk_bf16(bflo(v[0]) + p0[0], bfhi(v[0]) + p0[1]); o[1] = cvt_pk_bf16(bflo(v[1]) + p0[2], bfhi(v[1]) + p0[3]);
      o[2] = cvt_pk_bf16(bflo(v[2]) + p1[0], bfhi(v[2]) + p1[1]); o[3] = cvt_pk_bf16(bflo(v[3]) + p1[2], bfhi(v[3]) + p1[3]);
      r[i] = o;
    }
  }
};

template <class AL, class EP>
DEVI void gemm_run(char* lds, int Mt, int Nt, int K, const u16* __restrict__ Bt, AL al, const EP ep) {
  const int tid = threadIdx.x, wave = tid >> 6, lane = tid & 63, wm = wave >> 1, wn = wave & 1;
  const int lc = tid & 7, lr = tid >> 3, col = lane & 31, hh = lane >> 5;
  const int nk = K >> 6;
#define GBAR() do { asm volatile("s_waitcnt lgkmcnt(0)" ::: "memory"); __builtin_amdgcn_s_barrier(); asm volatile("" ::: "memory"); } while (0)
  constexpr int NS = AL::DEPTH;
  if (*(const unsigned*)(lds + 74240)) __builtin_amdgcn_s_sleep(20);
  const bool xsw = ((gridDim.x & 7) == 0) && ((Mt & 63) == 0);
  const int xcd = blockIdx.x & 7, nloc = gridDim.x >> 3, Mx = Mt >> 3;
  const int t_first = xsw ? (int)(blockIdx.x >> 3) : (int)blockIdx.x, t_step = xsw ? nloc : (int)gridDim.x, t_end = xsw ? Mx * Nt : Mt * Nt;
  for (int tile = t_first; tile < t_end; tile += t_step) {
    int tm, tn;
    if (xsw) { const int g = tile / (8 * Nt), within = tile - g * (8 * Nt); tn = within >> 3; tm = xcd * Mx + g * 8 + (within & 7); }
    else { tm = tile / Nt; tn = tile - tm * Nt; }
    al.setup(tm, tn);
    f32x16 acc[2][2];
#pragma unroll
    for (int a = 0; a < 2; ++a)
#pragma unroll
      for (int b = 0; b < 2; ++b)
#pragma unroll
        for (int i = 0; i < 16; ++i) acc[a][b][i] = 0.f;
    u32x4 ra[NS][4], rb[NS][4];
    const u16* bp = Bt + (size_t)(tn * 128 + lr) * K + lc * 8;
#define G_LOAD(set, kt_) do { al.load(ra[set], tm * 128 + lr, (kt_) * 64 + lc * 8); _Pragma("unroll") for (int i = 0; i < 4; ++i) rb[set][i] = *(const u32x4*)(bp + (size_t)i * 32 * K + (kt_) * 64); } while (0)
#define G_STORE(set, st_) do { char* da = lds + (st_) * 32768; _Pragma("unroll") for (int i = 0; i < 4; ++i) { *(u32x4*)(da + lds_off(AL::row(lr, i), lc)) = ra[set][i]; *(u32x4*)(da + 16384 + lds_off(lr + 32 * i, lc)) = rb[set][i]; } } while (0)
#define G_COMPUTE(st_) do { const char* sa = lds + (st_) * 32768; const char* sb = sa + 16384; \
      _Pragma("unroll") for (int ks = 0; ks < 4; ++ks) { bf16x8 af[2], bfr[2]; \
        _Pragma("unroll") for (int mi = 0; mi < 2; ++mi) af[mi] = *(const bf16x8*)(sa + lds_off(wm * 64 + mi * 32 + col, ks * 2 + hh)); \
        _Pragma("unroll") for (int ni = 0; ni < 2; ++ni) bfr[ni] = *(const bf16x8*)(sb + lds_off(wn * 64 + ni * 32 + col, ks * 2 + hh)); \
        _Pragma("unroll") for (int mi = 0; mi < 2; ++mi) _Pragma("unroll") for (int ni = 0; ni < 2; ++ni) acc[mi][ni] = __builtin_amdgcn_mfma_f32_32x32x16_bf16(bfr[ni], af[mi], acc[mi][ni], 0, 0, 0); } } while (0)
    if constexpr (NS == 1) {
      G_LOAD(0, 0); G_STORE(0, 0);
      GBAR();
      for (int kt = 0; kt < nk; ++kt) {
        const int st = kt & 1;
        if (kt + 1 < nk) G_LOAD(0, kt + 1);
        G_COMPUTE(st);
        if (kt + 1 < nk) G_STORE(0, st ^ 1);
        GBAR();
      }
    } else if (nk & 1) {
      G_LOAD(0, 0); G_STORE(0, 0);
      GBAR();
      for (int kt = 0; kt < nk; ++kt) {
        const int st = kt & 1;
        if (kt + 1 < nk) G_LOAD(0, kt + 1);
        G_COMPUTE(st);
        if (kt + 1 < nk) G_STORE(0, st ^ 1);
        GBAR();
      }
    } else {
      G_LOAD(0, 0);
      G_LOAD(1, 1);
      G_STORE(0, 0);
      GBAR();
      for (int kt = 0; kt < nk - 2; kt += 2) {
        G_LOAD(0, kt + 2);
        G_COMPUTE(0);
        asm volatile("s_waitcnt vmcnt(8)" ::: "memory");
        G_STORE(1, 1);
        GBAR();
        G_LOAD(1, kt + 3);
        G_COMPUTE(1);
        asm volatile("s_waitcnt vmcnt(8)" ::: "memory");
        G_STORE(0, 0);
        GBAR();
      }
      G_COMPUTE(0);
      asm volatile("s_waitcnt vmcnt(0)" ::: "memory");
      G_STORE(1, 1);
      GBAR();
      G_COMPUTE(1);
      GBAR();
    }
#undef G_LOAD
#undef G_STORE
#undef G_COMPUTE
#undef GBAR
    ep(acc, tm * 128 + wm * 64 + col, tn * 128 + wn * 64, hh);
  }
}
#define LDS3 __attribute__((address_space(3)))
DEVI int lds_off32(int row, int c) { return row * 64 + ((c ^ ((row >> 2) & 3)) << 4); }
template <class EP>
DEVI void gemm_dma(char* lds, int Mt, int Nt, int K, const u16* __restrict__ A, int lda, const u16* __restrict__ Bt, const EP ep) {
  const int tid = threadIdx.x, wave = __builtin_amdgcn_readfirstlane(tid >> 6), lane = tid & 63, wm = wave >> 1, wn = wave & 1;
  const int col = lane & 31, hh = lane >> 5;
  const int nk = K >> 5;
  if (*(const unsigned*)(lds + 74240)) __builtin_amdgcn_s_sleep(20);
  const bool xsw = ((gridDim.x & 7) == 0) && ((Mt & 63) == 0);
  const int xcd = blockIdx.x & 7, nloc = gridDim.x >> 3, Mx = Mt >> 3;
  const int t_first = xsw ? (int)(blockIdx.x >> 3) : (int)blockIdx.x, t_step = xsw ? nloc : (int)gridDim.x, t_end = xsw ? Mx * Nt : Mt * Nt;
  const unsigned lds_base = (unsigned)(size_t)(LDS3 char*)lds;
  for (int tile = t_first; tile < t_end; tile += t_step) {
    int tm, tn;
    if (xsw) { const int g = tile / (8 * Nt), within = tile - g * (8 * Nt); tn = within >> 3; tm = xcd * Mx + g * 8 + (within & 7); }
    else { tm = tile / Nt; tn = tile - tm * Nt; }
    f32x16 acc[4][2];
#pragma unroll
    for (int a = 0; a < 4; ++a)
#pragma unroll
      for (int b = 0; b < 2; ++b)
#pragma unroll
        for (int i = 0; i < 16; ++i) acc[a][b][i] = 0.f;
    unsigned aoff[4], boff[2];
#pragma unroll
    for (int q = 0; q < 4; ++q) { const int row = (q * 4 + wave) * 16 + (lane >> 2), c = (lane & 3) ^ ((row >> 2) & 3);
      aoff[q] = (unsigned)(((tm * 256 + row) * lda + c * 8) * 2); if (q < 2) boff[q] = (unsigned)(((tn * 128 + row) * K + c * 8) * 2); }
#define D_ISSUE(gp_, la_) asm volatile("s_mov_b32 m0, %0\n\tglobal_load_lds_dwordx4 %1, off" :: "s"(la_), "v"(gp_) : "memory", "m0")
#define D_STAGE(kt_, st_) do { _Pragma("unroll") for (int q = 0; q < 4; ++q) { \
      const unsigned la_ = (unsigned)__builtin_amdgcn_readfirstlane((int)(lds_base + (st_) * 24576 + (q * 4 + wave) * 1024)); \
      const char* ga_ = (const char*)A + aoff[q] + (size_t)(kt_) * 64; D_ISSUE(ga_, la_); \
      if (q < 2) { const char* gb_ = (const char*)Bt + boff[q] + (size_t)(kt_) * 64; const unsigned lb_ = la_ + 16384u; D_ISSUE(gb_, lb_); } } } while (0)
    D_STAGE(0, 0); D_STAGE(1, 1);
    int st = 0;
    for (int kt = 0; kt < nk; ++kt) {
      if (kt + 1 < nk) asm volatile("s_waitcnt vmcnt(6)" ::: "memory"); else asm volatile("s_waitcnt vmcnt(0)" ::: "memory");
      __builtin_amdgcn_s_barrier(); asm volatile("" ::: "memory");
      const int st2 = st == 0 ? 2 : st - 1;
      if (kt + 2 < nk) D_STAGE(kt + 2, st2);
      const char* sa = lds + st * 24576; const char* sb = sa + 16384;
#pragma unroll
      for (int ks = 0; ks < 2; ++ks) {
        bf16x8 af[4], bfr[2];
#pragma unroll
        for (int mi = 0; mi < 4; ++mi) af[mi] = *(const bf16x8*)(sa + lds_off32(wm * 128 + mi * 32 + col, ks * 2 + hh));
#pragma unroll
        for (int ni = 0; ni < 2; ++ni) bfr[ni] = *(const bf16x8*)(sb + lds_off32(wn * 64 + ni * 32 + col, ks * 2 + hh));
#pragma unroll
        for (int mi = 0; mi < 4; ++mi)
#pragma unroll
          for (int ni = 0; ni < 2; ++ni) acc[mi][ni] = __builtin_amdgcn_mfma_f32_32x32x16_bf16(bfr[ni], af[mi], acc[mi][ni], 0, 0, 0);
      }
      asm volatile("s_waitcnt lgkmcnt(0)" ::: "memory");
      st = st == 2 ? 0 : st + 1;
    }
    __builtin_amdgcn_s_barrier(); asm volatile("" ::: "memory");
#undef D_STAGE
#undef D_ISSUE
    ep(acc, tm * 256 + wm * 128 + col, tn * 128 + wn * 64, hh);
  }
}
#define EPI_LOOP for (int mi = 0; mi < 2; ++mi) for (int ni = 0; ni < 2; ++ni) for (int rr = 0; rr < 4; ++rr)

struct EpiRwkvProj {
  _Float16 *R, *K, *V, *Z;
  DEVI void operator()(const f32x16 (&acc)[2][2], int m0, int nb, int hh) const {
    const int c = nb >> 10; _Float16* dst = c == 0 ? R : c == 1 ? K : c == 2 ? V : Z; const int n0 = (nb & 1023) + 4 * hh;
#pragma unroll
    EPI_LOOP { h4 v; for (int e = 0; e < 4; ++e) v[e] = (_Float16)acc[mi][ni][rr * 4 + e];
      *(h4*)(dst + (size_t)(m0 + mi * 32) * 1024 + n0 + ni * 32 + rr * 8) = v; }
  }
};
struct EpiL1 {
  u16* HID;
  DEVI void operator()(const f32x16 (&acc)[2][2], int m0, int nb, int hh) const {
    if (nb == 64 || nb == 128) return;
    const int cb = nb ? 64 : 0;
#pragma unroll
    EPI_LOOP { float v[4]; for (int e = 0; e < 4; ++e) { float x = acc[mi][ni][rr * 4 + e]; v[e] = nb == 0 ? tanhf_(x) : x; }
      u32x2 w; w.x = cvt_pk_bf16(v[0], v[1]); w.y = cvt_pk_bf16(v[2], v[3]);
      *(u32x2*)(HID + (size_t)(m0 + mi * 32) * 128 + cb + 4 * hh + ni * 32 + rr * 8) = w; }
  }
};
template <int MODE> struct EpiL2 {
  _Float16* D; const float* bias;
  DEVI void operator()(const f32x16 (&acc)[2][2], int m0, int nb, int hh) const {
#pragma unroll
    EPI_LOOP { const int n = nb + 4 * hh + ni * 32 + rr * 8; const f32x4 bv = *(const f32x4*)(bias + n); h4 v;
      for (int e = 0; e < 4; ++e) { const float u = bv[e] + acc[mi][ni][rr * 4 + e]; float o;
        if (MODE == 0) o = __expf(-0.6065306597126334f * sigmoidf_(u));   else o = sigmoidf_(u);
        v[e] = (_Float16)o; }
      *(h4*)(D + (size_t)(m0 + mi * 32) * 1024 + n) = v; }
  }
};
struct EpiResid {
  const float* resid; float* out;
  template <int MI> DEVI void operator()(const f32x16 (&acc)[MI][2], int m0, int nb, int hh) const {
#pragma unroll
    for (int mi = 0; mi < MI; ++mi) for (int ni = 0; ni < 2; ++ni) for (int rr = 0; rr < 4; ++rr) { const size_t o = (size_t)(m0 + mi * 32) * 1024 + nb + 4 * hh + ni * 32 + rr * 8; f32x4 v = *(const f32x4*)(resid + o);
      for (int e = 0; e < 4; ++e) v[e] += acc[mi][ni][rr * 4 + e];
      *(f32x4*)(out + o) = v; }
  }
};
struct EpiNsaIn {
  char* ws; const float *q_gain, *k_gain; int nb0;
  template <int MI> DEVI void operator()(const f32x16 (&acc)[MI][2], int m0, int nb_, int hh) const {
    const int nb = nb_ + nb0;
    if (nb >= 3632) return;
    int kind; const float* gain = nullptr; float post = 1.f;
    u16* dst = nullptr; int gi = 0; bool norm = false;
    if (nb < 1024) { kind = 0; norm = true; gain = q_gain; post = 0.125f; }
    else if (nb < 2560) { const int seg = (nb - 1024) >> 8; gi = ((nb - 1024) >> 6) & 3;
      dst = (u16*)(ws + (seg == 0 ? OFF_KCR : seg == 1 ? OFF_VCR : seg == 2 ? OFF_KS : seg == 3 ? OFF_VST : seg == 4 ? OFF_KW : OFF_VWT));
      kind = (seg == 3 || seg == 5) ? 2 : 1; if (seg == 2) { norm = true; gain = k_gain + 64; } if (seg == 4) { norm = true; gain = k_gain + 128; } }
    else if (nb < 3584) kind = 3; else kind = 4;
#pragma unroll
    for (int mi = 0; mi < MI; ++mi) {
      const int m = m0 + mi * 32;
      float rinv = 1.f;
      if (norm) { float ss = 0.f;
#pragma unroll
        for (int ni = 0; ni < 2; ++ni)
#pragma unroll
          for (int i = 0; i < 16; ++i) ss += acc[mi][ni][i] * acc[mi][ni][i];
        ss += __shfl_xor(ss, 32); rinv = rsqrtf(ss * (1.f / 64.f) + 1e-6f) * post; }
#pragma unroll
      for (int ni = 0; ni < 2; ++ni)
#pragma unroll
        for (int rr = 0; rr < 4; ++rr) {
          const int d = 4 * hh + ni * 32 + rr * 8;
          float v[4];
#pragma unroll
          for (int e = 0; e < 4; ++e) v[e] = acc[mi][ni][rr * 4 + e];
          if (norm) { const f32x4 gv = *(const f32x4*)(gain + d);
#pragma unroll
            for (int e = 0; e < 4; ++e) v[e] *= rinv * gv[e]; }
          if (kind == 0) { u32x2 w; w.x = cvt_pk_bf16(v[0], v[1]); w.y = cvt_pk_bf16(v[2], v[3]); *(u32x2*)((u16*)(ws + OFF_Q) + (size_t)m * 1024 + nb + d) = w; }
          else if (kind == 1) { const int b = m >> 12, t = m & 4095; u32x2 w; w.x = cvt_pk_bf16(v[0], v[1]); w.y = cvt_pk_bf16(v[2], v[3]);
            *(u32x2*)(dst + (((size_t)(b * 4 + gi) * SEQ + t) << 6) + d) = w; }
          else if (kind == 2) { const int b = m >> 12, t = m & 4095;
#pragma unroll
            for (int e = 0; e < 4; ++e) dst[((size_t)(b * 4 + gi) * 64 + d + e) * SEQ + t] = (u16)(cvt_pk_bf16(v[e], 0.f) & 0xffff); }
          else if (kind == 3) { u32x2 w; w.x = cvt_pk_bf16(siluf_(v[0]), siluf_(v[1])); w.y = cvt_pk_bf16(siluf_(v[2]), siluf_(v[3]));
            *(u32x2*)((u16*)(ws + OFF_ZS) + (size_t)m * 1024 + (nb - 2560) + d) = w; }
          else { if (d < 48) { f32x4 o; for (int e = 0; e < 4; ++e) o[e] = sigmoidf_(v[e]); *(f32x4*)((float*)(ws + OFF_G) + (size_t)m * 48 + d) = o; } }
        }
    }
  }
};
struct EpiCmp1 {
  u16* HID; const float* b1;
  DEVI void operator()(const f32x16 (&acc)[2][2], int m0, int nb, int hh) const {
    const int which = nb >> 8; u16* Hd = HID + (size_t)which * 8192 * 256;
#pragma unroll
    EPI_LOOP { const int n = nb + 4 * hh + ni * 32 + rr * 8; const f32x4 bv = *(const f32x4*)(b1 + n); float v[4];
      for (int e = 0; e < 4; ++e) { const float x = acc[mi][ni][rr * 4 + e] + bv[e]; v[e] = 0.5f * x * (1.f + tanhf_(0.7978845608028654f * (x + 0.044715f * x * x * x))); }
      u32x2 w; w.x = cvt_pk_bf16(v[0], v[1]); w.y = cvt_pk_bf16(v[2], v[3]);
      *(u32x2*)(Hd + (size_t)(m0 + mi * 32) * 256 + (n & 255)) = w; }
  }
};
template <int WHICH> struct EpiCmp2 {
  u16* dst; const float* gain;
  DEVI void operator()(const f32x16 (&acc)[2][2], int m0, int nb, int hh) const {
    if (nb >= 64) return;
#pragma unroll
    for (int mi = 0; mi < 2; ++mi) {
      const int row = m0 + mi * 32; const int bg = row / 255, n = row - bg * 255;
      float rinv = 1.f;
      if (WHICH == 0) { float ss = 0.f;
#pragma unroll
        for (int ni = 0; ni < 2; ++ni)
#pragma unroll
          for (int i = 0; i < 16; ++i) ss += acc[mi][ni][i] * acc[mi][ni][i];
        ss += __shfl_xor(ss, 32); rinv = rsqrtf(ss * (1.f / 64.f) + 1e-6f); }
      if (row < 8160) {
#pragma unroll
        for (int ni = 0; ni < 2; ++ni)
#pragma unroll
          for (int rr = 0; rr < 4; ++rr) {
            const int d = 4 * hh + ni * 32 + rr * 8; float v[4];
#pragma unroll
            for (int e = 0; e < 4; ++e) v[e] = acc[mi][ni][rr * 4 + e];
            if (WHICH == 0) { const f32x4 gv = *(const f32x4*)(gain + d); u32x2 w; w.x = cvt_pk_bf16(v[0] * rinv * gv[0], v[1] * rinv * gv[1]); w.y = cvt_pk_bf16(v[2] * rinv * gv[2], v[3] * rinv * gv[3]);
              *(u32x2*)(dst + ((size_t)bg * 256 + n) * 64 + d) = w; }
            else {
#pragma unroll
              for (int e = 0; e < 4; ++e) dst[((size_t)bg * 64 + d + e) * 256 + n] = (u16)(cvt_pk_bf16(v[e], 0.f) & 0xffff); }
          }
      }
    }
  }
};

DEVI float allred8(float x) { x += dppf<0xB1>(x); x += dppf<0x4E>(x); x += dppf<0x141>(x); return x; }
DEVI void scan_phase(const Params& p, char* lds) {
  float* sR = (float*)lds;
  float* sV = sR + 5 * 2048;
  float* sP = sV + 1024;
  const _Float16* Rg = (const _Float16*)(p.ws + OFF_R); const _Float16* Kg = (const _Float16*)(p.ws + OFF_K); const _Float16* Vg = (const _Float16*)(p.ws + OFF_V);
  const _Float16* Wg = (const _Float16*)p.out; const _Float16* Ag = Wg + (size_t)NT * 1024;
  _Float16* Og = (_Float16*)(p.ws + OFF_O);
  const int tid = threadIdx.x, wave = tid >> 6, lane = tid & 63, rl = lane >> 3, sub = lane & 7, rowl = wave * 8 + rl;
  const int tt = tid >> 3, cc = tid & 7;
  for (int task = blockIdx.x; task < 256; task += gridDim.x) {
    const int bh = task >> 1, half = task & 1, b = bh >> 4, h = bh & 15;
    float kkc[8], kac[8], rkc[8];
#pragma unroll
    for (int i = 0; i < 8; ++i) { kkc[i] = p.k_k[h * 64 + cc * 8 + i]; kac[i] = p.k_a[h * 64 + cc * 8 + i]; rkc[i] = p.r_k[h * 64 + cc * 8 + i]; }
    float* BON = (float*)(p.ws + OFF_HID);
    size_t gb = ((size_t)b * SEQ + tt) * 1024 + h * 64 + cc * 8;
    h8 pr = *(const h8*)(Rg + gb), pk = *(const h8*)(Kg + gb), pv = *(const h8*)(Vg + gb), pw = *(const h8*)(Wg + gb), pa = *(const h8*)(Ag + gb);
    f32x2 S0 = {0.f, 0.f}, S1 = {0.f, 0.f}, S2 = {0.f, 0.f}, S3 = {0.f, 0.f};
    for (int c = 0; c < 128; ++c) {
      {
        float kf[8], af[8], kk[8]; float ss = 0.f;
#pragma unroll
        for (int i = 0; i < 8; ++i) { kf[i] = (float)pk[i]; af[i] = (float)pa[i]; kk[i] = kf[i] * kkc[i]; ss += kk[i] * kk[i]; }
        ss += __shfl_xor(ss, 1); ss += __shfl_xor(ss, 2); ss += __shfl_xor(ss, 4);
        const float inv = 1.f / fmaxf(sqrtf(ss), 1e-12f);
        const int o = tt * 64 + cc * 8;
        if (half == 0) {
          float bn = 0.f;
#pragma unroll
          for (int i = 0; i < 8; ++i) bn += (float)pr[i] * (kf[i] * (1.f + (af[i] - 1.f) * kac[i])) * rkc[i];
          bn += __shfl_xor(bn, 1); bn += __shfl_xor(bn, 2); bn += __shfl_xor(bn, 4);
          if (cc == 0) BON[((size_t)b * SEQ + c * 32 + tt) * 16 + h] = bn;
        }
        f32x4 v0, v1;
#define ST8(base, expr) do { for (int i = 0; i < 4; ++i) { { const int e = i; v0[i] = (expr); } { const int e = i + 4; v1[i] = (expr); } } *(f32x4*)((base) + o) = v0; *(f32x4*)((base) + o + 4) = v1; } while (0)
        ST8(sR, (float)pr[e]);
        ST8(sR + 2048, (float)pw[e]);
        ST8(sR + 4096, kf[e] * (1.f + (af[e] - 1.f) * kac[e]));
        ST8(sR + 6144, -(kk[e] * inv));
        ST8(sR + 8192, kk[e] * inv * af[e]);
#undef ST8
        if ((cc >> 2) == half) {
          for (int i = 0; i < 4; ++i) { v0[i] = (float)pv[i]; v1[i] = (float)pv[i + 4]; }
          *(f32x4*)(sV + tt * 32 + (cc & 3) * 8) = v0; *(f32x4*)(sV + tt * 32 + (cc & 3) * 8 + 4) = v1;
        }
      }
      __syncthreads();
      if (c + 1 < 128) { gb += (size_t)32 * 1024; pr = *(const h8*)(Rg + gb); pk = *(const h8*)(Kg + gb); pv = *(const h8*)(Vg + gb); pw = *(const h8*)(Wg + gb); pa = *(const h8*)(Ag + gb); }
      {
        const float* bR = sR + sub * 8; const float* bV = sV + rowl; float* bP = sP + rowl * 2 + (sub >> 2);
        f32x4 r0 = *(const f32x4*)(bR), r1 = *(const f32x4*)(bR + 4), w0 = *(const f32x4*)(bR + 2048), w1 = *(const f32x4*)(bR + 2052),
              k0 = *(const f32x4*)(bR + 4096), k1 = *(const f32x4*)(bR + 4100), n0 = *(const f32x4*)(bR + 6144), n1 = *(const f32x4*)(bR + 6148),
              a0 = *(const f32x4*)(bR + 8192), a1 = *(const f32x4*)(bR + 8196);
        float vv = bV[0];
#pragma unroll 2
        for (int t = 0; t < 32; ++t) {
          const int tn = t < 31 ? t + 1 : 31; const float* q = bR + tn * 64;
          const f32x4 r0n = *(const f32x4*)(q), r1n = *(const f32x4*)(q + 4), w0n = *(const f32x4*)(q + 2048), w1n = *(const f32x4*)(q + 2052),
                      k0n = *(const f32x4*)(q + 4096), k1n = *(const f32x4*)(q + 4100), n0n = *(const f32x4*)(q + 6144), n1n = *(const f32x4*)(q + 6148),
                      a0n = *(const f32x4*)(q + 8192), a1n = *(const f32x4*)(q + 8196);
          const float vvn = bV[tn * 32];
#define LO(x) ((f32x2){x[0], x[1]})
#define HI(x) ((f32x2){x[2], x[3]})
          const f32x2 vv2 = {vv, vv};
          f32x2 spa = S0 * LO(n0); spa = S1 * HI(n0) + spa;
          f32x2 spb = S2 * LO(n1); spb = S3 * HI(n1) + spb;
          const f32x2 sp = spa + spb;
          float sa = sp.x + sp.y;
          const f32x2 t0 = S0 * LO(w0) + vv2 * LO(k0), t1 = S1 * HI(w0) + vv2 * HI(k0), t2 = S2 * LO(w1) + vv2 * LO(k1), t3 = S3 * HI(w1) + vv2 * HI(k1);
          sa = allred8(sa);
          const f32x2 sa2 = {sa, sa};
          S0 = t0 + sa2 * LO(a0); S1 = t1 + sa2 * HI(a0); S2 = t2 + sa2 * LO(a1); S3 = t3 + sa2 * HI(a1);
          f32x2 oa = S0 * LO(r0); oa = S1 * HI(r0) + oa;
          f32x2 ob = S2 * LO(r1); ob = S3 * HI(r1) + ob;
          const f32x2 op = oa + ob;
          float o = op.x + op.y;
          o += dppf<0xB1>(o); o += dppf<0x4E>(o);
          bP[t * 64] = o;
#undef LO
#undef HI
          r0 = r0n; r1 = r1n; w0 = w0n; w1 = w1n; k0 = k0n; k1 = k1n; n0 = n0n; n1 = n1n; a0 = a0n; a1 = a1n; vv = vvn;
        }
      }
      __syncthreads();
      {
        const int t = tid >> 3, r4 = (tid & 7) * 4;
        const f32x4 q0 = *(const f32x4*)(sP + (t * 32 + r4) * 2), q1 = *(const f32x4*)(sP + (t * 32 + r4) * 2 + 4);
        h4 ov; ov[0] = (_Float16)(q0[0] + q0[1]); ov[1] = (_Float16)(q0[2] + q0[3]); ov[2] = (_Float16)(q1[0] + q1[1]); ov[3] = (_Float16)(q1[2] + q1[3]);
        *(h4*)(Og + ((size_t)b * SEQ + c * 32 + t) * 1024 + h * 64 + half * 32 + r4) = ov;
      }
    }
    __syncthreads();
  }
}
DEVI void post_phase(const Params& p) {
  const _Float16* Vg = (const _Float16*)(p.ws + OFF_V); const _Float16* Zg = (const _Float16*)(p.ws + OFF_Z); const _Float16* Og = (const _Float16*)(p.ws + OFF_O);
  const float* BON = (const float*)(p.ws + OFF_HID);
  u16* Y = (u16*)(p.ws + OFF_Y);
  for (int idx = blockIdx.x * 256 + threadIdx.x; idx < NT * 128; idx += gridDim.x * 256) {
    const int c8 = idx & 127; const size_t off = (size_t)(idx >> 7) * 1024 + c8 * 8; const int ch = c8 * 8;
    const h8 o = *(const h8*)(Og + off), v = *(const h8*)(Vg + off), z = *(const h8*)(Zg + off);
    const float bn = BON[(size_t)(idx >> 7) * 16 + (c8 >> 3)];
    float of[8]; float s = 0.f;
#pragma unroll
    for (int i = 0; i < 8; ++i) { of[i] = (float)o[i]; s += of[i]; }
    s += __shfl_xor(s, 1); s += __shfl_xor(s, 2); s += __shfl_xor(s, 4);
    const float mean = s * (1.f / 64.f); float q = 0.f;
#pragma unroll
    for (int i = 0; i < 8; ++i) { const float d = of[i] - mean; q += d * d; }
    q += __shfl_xor(q, 1); q += __shfl_xor(q, 2); q += __shfl_xor(q, 4);
    const float rstd = rsqrtf(q * (1.f / 64.f) + 64e-5f);
    float y[8];
#pragma unroll
    for (int i = 0; i < 8; ++i) { const float on = (of[i] - mean) * rstd * p.lnx_g[ch + i] + p.lnx_b[ch + i] + bn * (float)v[i]; y[i] = on * siluf_((float)z[i]); }
    u32x4 w; w[0] = cvt_pk_bf16(y[0], y[1]); w[1] = cvt_pk_bf16(y[2], y[3]); w[2] = cvt_pk_bf16(y[4], y[5]); w[3] = cvt_pk_bf16(y[6], y[7]);
    *(u32x4*)(Y + off) = w;
  }
}

constexpr float NEGINF = -__builtin_huge_valf();
constexpr float LOG2E = 1.4426950408889634f;
template <int MODE>
DEVI void attn_branch(char* lds, u64 tilemask, const u16* __restrict__ Kg, const u16* __restrict__ Vg, int vpitch, int lo, int hi, u64 selbits,
                      const bf16x8 (&qf)[4], const float m, float& l, f32x16 (&O)[2], float inv_l, float* imp_row) {
  if (!tilemask) return;
  const int tid = threadIdx.x, wave = __builtin_amdgcn_readfirstlane(tid >> 6), lane = tid & 63, col = lane & 31, hh = lane >> 5;
  const unsigned lds_base = (unsigned)(size_t)(LDS3 char*)lds;
  int koff[2], voff[2];
#pragma unroll
  for (int q = 0; q < 2; ++q) { const int row = (q * 4 + wave) * 8 + (lane >> 3), c = (lane & 7) ^ ((row >> 1) & 7); koff[q] = row * 64 + c * 8; voff[q] = row * vpitch + c * 8; }
#define A_DMA(gp_, la_) asm volatile("s_mov_b32 m0, %0\n\tglobal_load_lds_dwordx4 %1, off" :: "s"(la_), "v"(gp_) : "memory", "m0")
#define A_ISSUE(j_, st_) do { _Pragma("unroll") for (int q = 0; q < 2; ++q) { \
    const unsigned la_ = (unsigned)__builtin_amdgcn_readfirstlane((int)(lds_base + (st_) * 16384 + (q * 4 + wave) * 1024)); \
    const u16* gk_ = Kg + (size_t)(j_) * 4096 + koff[q]; A_DMA(gk_, la_); \
    const u16* gv_ = Vg + (size_t)(j_) * 64 + voff[q]; const unsigned lv_ = la_ + 8192u; A_DMA(gv_, lv_); } } while (0)
  int j = __builtin_ctzll(tilemask); tilemask &= tilemask - 1;
  int j1 = -1, j2 = -1;
  if (tilemask) { j1 = __builtin_ctzll(tilemask); tilemask &= tilemask - 1; }
  if (tilemask) { j2 = __builtin_ctzll(tilemask); tilemask &= tilemask - 1; }
  A_ISSUE(j, 0);
  if (j1 >= 0) A_ISSUE(j1, 1);
  if (j2 >= 0) A_ISSUE(j2, 2);
  int st = 0; float carry = 0.f;
  while (true) {
    if (j2 >= 0) asm volatile("s_waitcnt vmcnt(8)" ::: "memory"); else if (j1 >= 0) asm volatile("s_waitcnt vmcnt(4)" ::: "memory"); else asm volatile("s_waitcnt vmcnt(0)" ::: "memory");
    __builtin_amdgcn_s_barrier(); asm volatile("" ::: "memory");
    int j3 = -1;
    if (tilemask) { j3 = __builtin_ctzll(tilemask); tilemask &= tilemask - 1; const int st3 = (st + 3) & 3; A_ISSUE(j3, st3); }
    const char* kb = lds + st * 16384; const char* vb = kb + 8192;
    f32x16 s[2];
#pragma unroll
    for (int nt = 0; nt < 2; ++nt)
#pragma unroll
      for (int i = 0; i < 16; ++i) s[nt][i] = 0.f;
    bf16x8 kfr[4][2];
#pragma unroll
    for (int ks = 0; ks < 4; ++ks)
#pragma unroll
      for (int nt = 0; nt < 2; ++nt) kfr[ks][nt] = *(const bf16x8*)(kb + lds_off(nt * 32 + col, ks * 2 + hh));
    __builtin_amdgcn_sched_barrier(0);
#pragma unroll
    for (int ks = 0; ks < 4; ++ks)
#pragma unroll
      for (int nt = 0; nt < 2; ++nt) s[nt] = __builtin_amdgcn_mfma_f32_32x32x16_bf16(kfr[ks][nt], qf[ks], s[nt], 0, 0, 0);
    u32x2 vfr[2][2][2][2];
    if (MODE != 0) {
#pragma unroll
      for (int nt = 0; nt < 2; ++nt)
#pragma unroll
        for (int k2 = 0; k2 < 2; ++k2)
#pragma unroll
          for (int dt = 0; dt < 2; ++dt) { const int c0 = nt * 4 + 2 * k2, d = dt * 32 + col, sw = (d >> 1) & 7;
            vfr[nt][k2][dt][0] = *(const u32x2*)(vb + d * 128 + ((c0 ^ sw) << 4) + 8 * hh); vfr[nt][k2][dt][1] = *(const u32x2*)(vb + d * 128 + (((c0 + 1) ^ sw) << 4) + 8 * hh); }
      __builtin_amdgcn_sched_barrier(0);
    }
    const int k0 = j * 64; const bool flag = (selbits >> j) & 1;
    const bool finv = !flag || hi < k0 || lo > k0 + 63 || hi < lo;
    const bool full = !finv && lo <= k0 && hi >= k0 + 63;
    if (__builtin_amdgcn_ballot_w64(!finv && !full) != 0ull) {
      asm volatile("; boundary-mask path" ::: "memory");
      const unsigned span = (unsigned)(hi - lo); const int b0 = k0 + 4 * hh - lo;
#pragma unroll
      for (int nt = 0; nt < 2; ++nt)
#pragma unroll
        for (int i = 0; i < 16; ++i) if ((unsigned)(b0 + nt * 32 + (i & 3) + 8 * (i >> 2)) > span) s[nt][i] = NEGINF;
    }
    const float nb = finv ? NEGINF : (MODE == 2 ? inv_l : -m);
    f32x2 ps2 = {0.f, 0.f};
#pragma unroll
    for (int nt = 0; nt < 2; ++nt)
#pragma unroll
      for (int i = 0; i < 16; i += 2) {
        f32x2 x = {s[nt][i], s[nt][i + 1]}; const f32x2 c2 = {LOG2E, LOG2E}, nb2 = {nb, nb};
        x = x * c2 + nb2;
        f32x2 pv; pv.x = __builtin_amdgcn_exp2f(x.x); pv.y = __builtin_amdgcn_exp2f(x.y);
        s[nt][i] = pv.x; s[nt][i + 1] = pv.y; ps2 += pv;
      }
    if (MODE != 2) l += ps2.x + ps2.y;
    if (MODE != 0) {
#pragma unroll
      for (int nt = 0; nt < 2; ++nt)
#pragma unroll
        for (int k2 = 0; k2 < 2; ++k2) {
          u32x4 pw;
#pragma unroll
          for (int e = 0; e < 4; ++e) pw[e] = cvt_pk_bf16(s[nt][8 * k2 + 2 * e], s[nt][8 * k2 + 2 * e + 1]);
          const bf16x8 pf = __builtin_bit_cast(bf16x8, pw);
#pragma unroll
          for (int dt = 0; dt < 2; ++dt) {
            const u32x2 v0 = vfr[nt][k2][dt][0], v1 = vfr[nt][k2][dt][1];
            const u32x4 vw = (u32x4){v0.x, v0.y, v1.x, v1.y};
            O[dt] = __builtin_amdgcn_mfma_f32_32x32x16_bf16(__builtin_bit_cast(bf16x8, vw), pf, O[dt], 0, 0, 0);
          }
        }
    }
    if (MODE == 2) {
      float rc[2][4], Gv[2][4];
#pragma unroll
      for (int nt = 0; nt < 2; ++nt)
#pragma unroll
        for (int rr = 0; rr < 4; ++rr) { Gv[nt][rr] = (s[nt][4 * rr] + s[nt][4 * rr + 1]) + (s[nt][4 * rr + 2] + s[nt][4 * rr + 3]); rc[nt][rr] = __shfl_xor(s[nt][4 * rr + 3], 32); }
#pragma unroll
      for (int nt = 0; nt < 2; ++nt)
#pragma unroll
        for (int rr = 0; rr < 4; ++rr) {
          const float prev = rr > 0 ? rc[nt][rr > 0 ? rr - 1 : 0] : (nt > 0 ? rc[0][3] : carry);
          float val = Gv[nt][rr] + (hh ? rc[nt][rr] : prev);
          val = quadsum(val);
          if ((col & 3) == 0) imp_row[j * 16 + nt * 8 + rr * 2 + hh] = val;
        }
      carry = rc[1][3];
    }
    asm volatile("s_waitcnt lgkmcnt(0)" ::: "memory");
    if (j1 < 0) break;
    j = j1; j1 = j2; j2 = j3; st = (st + 1) & 3;
  }
  __builtin_amdgcn_s_barrier(); asm volatile("" ::: "memory");
#undef A_ISSUE
#undef A_DMA
}

DEVI void attn_phase(const Params& p, char* lds) {
  float* imp = (float*)(lds + 65536);
  u64* wun = (u64*)(lds + 65536 + 8448);
  const u16* Q = (const u16*)(p.ws + OFF_Q); const u16* ZS = (const u16*)(p.ws + OFF_ZS); const float* G = (const float*)(p.ws + OFF_G);
  u16* Y = (u16*)(p.ws + OFF_Y);
  const int tid = threadIdx.x, wave = tid >> 6, lane = tid & 63, col = lane & 31, hh = lane >> 5;
  const int tok_l = wave * 8 + (col >> 2), head_l = col & 3;
  const int rpr = gridDim.x >> 5;
  float mb_cmp, mb_slc, mb_win;
  { float gq = fabsf(p.q_gain[lane]), g0_ = fabsf(p.k_gain[lane]), g1_ = fabsf(p.k_gain[64 + lane]), g2_ = fabsf(p.k_gain[128 + lane]);
#pragma unroll
    for (int o = 1; o < 64; o <<= 1) { gq = fmaxf(gq, __shfl_xor(gq, o)); g0_ = fmaxf(g0_, __shfl_xor(g0_, o)); g1_ = fmaxf(g1_, __shfl_xor(g1_, o)); g2_ = fmaxf(g2_, __shfl_xor(g2_, o)); }
    mb_cmp = 8.f * gq * g0_ * LOG2E; mb_slc = 8.f * gq * g1_ * LOG2E; mb_win = 8.f * gq * g2_ * LOG2E; }
  if (*(const unsigned*)(lds + 74240)) __builtin_amdgcn_s_sleep(40);
  for (int item = blockIdx.x; item < 4096; item += gridDim.x) {
    int rank = item >> 5; const int bg = item & 31;
    if ((gridDim.x & 31) == 0) { const int rnd = item / gridDim.x; if (rnd & 1) rank = rnd * rpr + (rpr - 1 - (rank - rnd * rpr)); }
    const int qb = 127 - rank, b = bg >> 2, g = bg & 3, q0 = qb * 32, t = q0 + tok_l, head = g * 4 + head_l;
    const size_t tokg = (size_t)b * SEQ + t;
    bf16x8 qf[4];
#pragma unroll
    for (int s = 0; s < 4; ++s) qf[s] = *(const bf16x8*)(Q + tokg * 1024 + head * 64 + s * 16 + hh * 8);
    for (int i = tid; i < 32 * 65; i += 256) imp[i] = 0.f;
    f32x16 O[2];
    f32x16 fin[2];
#pragma unroll
    for (int dt = 0; dt < 2; ++dt)
#pragma unroll
      for (int i = 0; i < 16; ++i) { O[dt][i] = 0.f; }
    const float g0 = G[tokg * 48 + 0 * 16 + head], g1 = G[tokg * 48 + 1 * 16 + head], g2 = G[tokg * 48 + 2 * 16 + head];
    {
      const u16* KC = (const u16*)(p.ws + OFF_KC) + (size_t)bg * 256 * 64; const u16* VC = (const u16*)(p.ws + OFF_VCT) + (size_t)bg * 64 * 256;
      const int ntile = ((q0 >> 4) >> 6) + 1; const u64 tmask = (ntile >= 64) ? ~0ull : ((1ull << ntile) - 1);
      const int nmax = t >= 31 ? ((t - 31) >> 4) : -1;
      float l = 0.f;
      attn_branch<0>(lds, tmask, KC, VC, 256, 0, nmax, ~0ull, qf, mb_cmp, l, O, 0.f, nullptr);
      l += __shfl_xor(l, 32);
      const float nbc = l > 0.f ? (-__log2f(l) - mb_cmp) : NEGINF;
      attn_branch<2>(lds, tmask, KC, VC, 256, 0, nmax, ~0ull, qf, mb_cmp, l, O, nbc, imp + tok_l * 65);
#pragma unroll
      for (int dt = 0; dt < 2; ++dt)
#pragma unroll
        for (int i = 0; i < 16; ++i) { fin[dt][i] = g0 * O[dt][i]; O[dt][i] = 0.f; }
    }
    __syncthreads();
    u64 mysel = 0, wu = 0;
#pragma unroll 1
    for (int tk = 0; tk < 8; ++tk) {
      const int tkn = q0 + wave * 8 + tk, jt = tkn >> 6, jj = lane;
      const bool valid = jj <= jt; const bool forced = (jj == 0) || (jj == jt) || (jj == jt - 1);
      const float sc = imp[(wave * 8 + tk) * 65 + jj] + (forced ? 1e4f : 0.f);
      const unsigned key = __float_as_uint(sc);
      const u64 vm = __ballot(valid);
      u64 mask = vm;
      if (__popcll(vm) > 16) {
        unsigned T = 0;
#pragma unroll 1
        for (int bb = 30; bb >= 0; --bb) { const unsigned cand = T | (1u << bb); if (__popcll(__ballot(key >= cand) & vm) >= 16) T = cand; }
        const u64 gt = __ballot(key > T) & vm, eq = __ballot(key == T) & vm;
        const int need = 16 - (int)__popcll(gt);
        const int rank = (int)__builtin_amdgcn_mbcnt_hi((unsigned)(eq >> 32), __builtin_amdgcn_mbcnt_lo((unsigned)eq, 0u));
        mask = gt | (__ballot(key == T && rank < need) & vm);
      }
      if ((col >> 2) == tk) mysel = mask;
      wu |= mask;
    }
    if (lane == 0) wun[wave] = wu;
    __syncthreads();
    const u64 un = wun[0] | wun[1] | wun[2] | wun[3];
    {
      const u16* KS = (const u16*)(p.ws + OFF_KS) + (size_t)bg * SEQ * 64; const u16* VS = (const u16*)(p.ws + OFF_VST) + (size_t)bg * 64 * SEQ;
      float l = 0.f;
      attn_branch<1>(lds, un, KS, VS, SEQ, 0, t, mysel, qf, mb_slc, l, O, 0.f, nullptr);
      l += __shfl_xor(l, 32); const float sc = l > 0.f ? g1 / l : 0.f;
#pragma unroll
      for (int dt = 0; dt < 2; ++dt)
#pragma unroll
        for (int i = 0; i < 16; ++i) { fin[dt][i] += sc * O[dt][i]; O[dt][i] = 0.f; }
    }
    {
      const u16* KW = (const u16*)(p.ws + OFF_KW) + (size_t)bg * SEQ * 64; const u16* VW = (const u16*)(p.ws + OFF_VWT) + (size_t)bg * 64 * SEQ;
      const int jlo = (q0 > 511 ? q0 - 511 : 0) >> 6, jhi = (q0 + 31) >> 6;
      const u64 hi_m = (jhi >= 63) ? ~0ull : ((1ull << (jhi + 1)) - 1); const u64 tmask = hi_m & ~((1ull << jlo) - 1);
      float l = 0.f;
      attn_branch<1>(lds, tmask, KW, VW, SEQ, t - 511, t, ~0ull, qf, mb_win, l, O, 0.f, nullptr);
      l += __shfl_xor(l, 32); const float sc = l > 0.f ? g2 / l : 0.f;
#pragma unroll
      for (int dt = 0; dt < 2; ++dt)
#pragma unroll
        for (int i = 0; i < 16; ++i) O[dt][i] = fin[dt][i] + sc * O[dt][i];
    }
#pragma unroll
    for (int dt = 0; dt < 2; ++dt)
#pragma unroll
      for (int rr = 0; rr < 4; ++rr) {
        const size_t o = tokg * 1024 + head * 64 + dt * 32 + rr * 8 + 4 * hh;
        const u32x2 z = *(const u32x2*)(ZS + o); u32x2 w;
        w.x = cvt_pk_bf16(O[dt][rr * 4 + 0] * bflo(z.x), O[dt][rr * 4 + 1] * bfhi(z.x)); w.y = cvt_pk_bf16(O[dt][rr * 4 + 2] * bflo(z.y), O[dt][rr * 4 + 3] * bfhi(z.y));
        *(u32x2*)(Y + o) = w;
      }
  }
}


#define XB_TMO      128
#define XB_XCNT(j)  (256  + 64 * (j))
#define XB_XSUB(j)  (1280 + 64 * (j))
#define XB_XGEN(j)  (2304 + 64 * (j))
#define XB_TOP      3328
#define XB_TOPGEN   3392
#define XCD_BAR_WORDS 3456
#define XB_SPIN_CAP (1u << 22)
#define LAS __attribute__((address_space(3)))
DEVI unsigned xb_ld(unsigned* p)              { return __hip_atomic_load(p, __ATOMIC_RELAXED, __HIP_MEMORY_SCOPE_AGENT); }
DEVI unsigned xb_add(unsigned* p, unsigned v) { return __hip_atomic_fetch_add(p, v, __ATOMIC_RELAXED, __HIP_MEMORY_SCOPE_AGENT); }
DEVI unsigned xb_xcc_id() { return (unsigned)__builtin_amdgcn_s_getreg((3 << 11) | 20) & 0xFu; }
#define XB_SPIN(cond, bar) do { unsigned _sp = 0; while (cond) { __builtin_amdgcn_s_sleep(1); \
    if ((++_sp & 255u) == 0u) { if (xb_ld(&(bar)[XB_TMO])) break; if (_sp > XB_SPIN_CAP) { atomicAdd(&(bar)[XB_TMO], 1u); break; } } } } while (0)
struct XcdBarrier { unsigned* bar; unsigned x; volatile LAS unsigned* st; };
DEVI XcdBarrier xcd_barrier_post(unsigned* bar, volatile LAS unsigned* st) {
  XcdBarrier b; b.bar = bar; b.x = xb_xcc_id(); b.st = st;
  if (threadIdx.x == 0) (void)xb_add(&bar[XB_XCNT(b.x)], 1u);
  return b;
}
DEVI void xcd_barrier_complete(unsigned* bar, unsigned x, unsigned& nloc, unsigned& nx) {
  const unsigned G = gridDim.x;
  unsigned sum, cnt, mine, sp = 0u;
  for (;;) {
    sum = 0u; cnt = 0u; mine = 0u;
#pragma unroll
    for (unsigned j = 0; j < 16; ++j) { const unsigned c = xb_ld(&bar[XB_XCNT(j)]); sum += c; cnt += (c > 0u) ? 1u : 0u; mine = (j == x) ? c : mine; }
    if (sum == G) break;
    __builtin_amdgcn_s_sleep(1);
    if ((++sp & 255u) == 0u) { if (xb_ld(&bar[XB_TMO])) break; if (sp > XB_SPIN_CAP) { atomicAdd(&bar[XB_TMO], 1u); break; } }
  }
  nloc = mine > 0u ? mine : 1u; nx = cnt > 0u ? cnt : 1u;
}
DEVI void xcd_barrier(const XcdBarrier& b) {
  asm volatile("s_waitcnt vmcnt(0)" ::: "memory");
  __syncthreads();
  if (threadIdx.x == 0) {
    unsigned* bar = b.bar;
    __builtin_amdgcn_s_waitcnt(0);
    unsigned nloc = b.st[0], nx = b.st[1];
    if (nloc == 0u) { xcd_barrier_complete(bar, b.x, nloc, nx); b.st[0] = nloc; b.st[1] = nx; }
    const unsigned old = xb_add(&bar[XB_XSUB(b.x)], 1u);
    const unsigned gen = old / nloc;
    if (old + 1u == (gen + 1u) * nloc) {
      __builtin_amdgcn_fence(__ATOMIC_RELEASE, "agent");
      asm volatile("s_waitcnt vmcnt(0)" ::: "memory");
      const unsigned og = xb_add(&bar[XB_TOP], 1u);
      const unsigned tg = og / nx;
      if (og + 1u == (tg + 1u) * nx) xb_add(&bar[XB_TOPGEN], 1u);
      else XB_SPIN(xb_ld(&bar[XB_TOPGEN]) == tg, bar);
      __builtin_amdgcn_fence(__ATOMIC_ACQUIRE, "agent");
      xb_add(&bar[XB_XGEN(b.x)], 1u);
      asm volatile("s_waitcnt vmcnt(0)" ::: "memory");
    } else {
      XB_SPIN(xb_ld(&bar[XB_XGEN(b.x)]) == gen, bar);
      __builtin_amdgcn_fence(__ATOMIC_ACQUIRE, "agent");
      asm volatile("s_waitcnt vmcnt(0)" ::: "memory");
    }
  }
  __syncthreads();
}
constexpr int NPHASE = 12;
#ifndef PHSEL
#define PHSEL 0xFFFu
#endif
#define PHON(n) if (!((PHSEL >> (n)) & 1u)) break;
__global__ void __launch_bounds__(256, 2) mega(Params p, int ph_lo, int ph_hi) {
  __shared__ __attribute__((aligned(16))) char lds[74304];
  char* ws = p.ws;
  __shared__ uint4 xb_words;
  if (threadIdx.x == 0) {
    xb_words = make_uint4(0u, 0u, 0u, 0u);
    const unsigned hw = (unsigned)__builtin_amdgcn_s_getreg(((8 - 1) << 11) | (8 << 6) | 4);
    const unsigned key = ((xcc_id_() & 7u) << 8) | (hw & 0xffu);
    *(unsigned*)(lds + 74240) = __hip_atomic_fetch_add((unsigned*)(ws + OFF_BAR) + 4096 + key, 1u, __ATOMIC_RELAXED, __HIP_MEMORY_SCOPE_AGENT) & 1u;
  }
  __syncthreads();
  XcdBarrier gb;
  if (ph_hi - ph_lo > 1) gb = xcd_barrier_post((unsigned*)(ws + OFF_BAR), (volatile LAS unsigned*)&xb_words); else { gb.bar = nullptr; gb.x = 0; gb.st = nullptr; }
  if (ph_lo < 0) cg::this_grid().sync();
  if (((PHSEL >> 0) & 1u) && ph_lo <= 0 && 0 < ph_hi) {
        cvt_job(lds, p.w_in, 1024, 4096, 4096, (u16*)(ws + WT_IN), 1024);
        cvt_job(lds, p.w1, 1024, 64, 64, (u16*)(ws + WT_L1), 1024);
        cvt_job(lds, p.a1, 1024, 64, 64, (u16*)(ws + WT_L1) + 192 * 1024, 1024);
        zero_job((u16*)(ws + WT_L1) + 64 * 1024, 128, 1024, 1024);
        cvt_job(lds, p.w2, 64, 1024, 1024, (u16*)(ws + WT_W2), 64);
        cvt_job(lds, p.a2, 64, 1024, 1024, (u16*)(ws + WT_A2), 64);
        cvt_job(lds, p.w_out, 1024, 1024, 1024, (u16*)(ws + WT_OUT), 1024);
        cvt_job(lds, p.n_w_in, 1024, 3632, 3712, (u16*)(ws + WT_NIN), 1024);
        cvt_job(lds, p.cmp_w1, 2048, 256, 256, (u16*)(ws + WT_C1), 2048);
        cvt_job(lds, p.cmp_w1 + 2048 * 256, 2048, 256, 256, (u16*)(ws + WT_C1) + 256 * 2048, 2048);
        cvt_job(lds, p.cmp_w2, 256, 64, 128, (u16*)(ws + WT_C2), 256);
        cvt_job(lds, p.cmp_w2 + 256 * 64, 256, 64, 128, (u16*)(ws + WT_C2) + 128 * 256, 256);
        cvt_job(lds, p.n_w_out, 1024, 1024, 1024, (u16*)(ws + WT_NOUT), 1024);
        rmsnorm_phase(p.x, p.norm_g, (u16*)(ws + OFF_H));
  }
  if (ph_lo <= 0 && 0 + 1 < ph_hi) xcd_barrier(gb);
  if (((PHSEL >> 1) & 1u) && ph_lo <= 1 && 1 < ph_hi) {
        gemm_run(lds, 256, 32, 1024, (const u16*)(ws + WT_IN), ALMix{(const u16*)(ws + OFF_H), p.mu, 0, 0},
                 EpiRwkvProj{(_Float16*)(ws + OFF_R), (_Float16*)(ws + OFF_K), (_Float16*)(ws + OFF_V), (_Float16*)(ws + OFF_Z)});
        gemm_run(lds, 256, 2, 1024, (const u16*)(ws + WT_L1), ALMix{(const u16*)(ws + OFF_H), p.mu, 1, 0}, EpiL1{(u16*)(ws + OFF_HID)});
  }
  if (ph_lo <= 1 && 1 + 1 < ph_hi) xcd_barrier(gb);
  if (((PHSEL >> 2) & 1u) && ph_lo <= 2 && 2 < ph_hi) {
        gemm_run(lds, 256, 8, 64, (const u16*)(ws + WT_W2), ALPlain{(const u16*)(ws + OFF_HID), 128}, EpiL2<0>{(_Float16*)p.out, p.w0});
        gemm_run(lds, 256, 8, 64, (const u16*)(ws + WT_A2), ALPlain{(const u16*)(ws + OFF_HID) + 64, 128}, EpiL2<1>{(_Float16*)p.out + (size_t)NT * 1024, p.a0});
  }
  if (ph_lo <= 2 && 2 + 1 < ph_hi) xcd_barrier(gb);
  if (((PHSEL >> 3) & 1u) && ph_lo <= 3 && 3 < ph_hi) { scan_phase(p, lds); }
  if (ph_lo <= 3 && 3 + 1 < ph_hi) xcd_barrier(gb);
  if (((PHSEL >> 4) & 1u) && ph_lo <= 4 && 4 < ph_hi) { post_phase(p); }
  if (ph_lo <= 4 && 4 + 1 < ph_hi) xcd_barrier(gb);
  if (((PHSEL >> 5) & 1u) && ph_lo <= 5 && 5 < ph_hi) { gemm_dma(lds, 128, 8, 1024, (const u16*)(ws + OFF_Y), 1024, (const u16*)(ws + WT_OUT), EpiResid{p.x, p.out}); }
  if (ph_lo <= 5 && 5 + 1 < ph_hi) xcd_barrier(gb);
  if (((PHSEL >> 6) & 1u) && ph_lo <= 6 && 6 < ph_hi) { rmsnorm_phase(p.out, p.norm_g + 1024, (u16*)(ws + OFF_H)); }
  if (ph_lo <= 6 && 6 + 1 < ph_hi) xcd_barrier(gb);
  if (((PHSEL >> 7) & 1u) && ph_lo <= 7 && 7 < ph_hi) {
    gemm_dma(lds, 128, 28, 1024, (const u16*)(ws + OFF_H), 1024, (const u16*)(ws + WT_NIN), EpiNsaIn{ws, p.q_gain, p.k_gain, 0});
    gemm_run(lds, 256, 1, 1024, (const u16*)(ws + WT_NIN) + (size_t)28 * 128 * 1024, ALPlain{(const u16*)(ws + OFF_H), 1024}, EpiNsaIn{ws, p.q_gain, p.k_gain, 28 * 128});
  }
  if (ph_lo <= 7 && 7 + 1 < ph_hi) xcd_barrier(gb);
  if (((PHSEL >> 8) & 1u) && ph_lo <= 8 && 8 < ph_hi) {
        gemm_run(lds, 64, 4, 2048, (const u16*)(ws + WT_C1), ALCmp{(const u16*)(ws + OFF_KCR), (const u16*)(ws + OFF_VCR), p.cmp_pe, nullptr, nullptr}, EpiCmp1{(u16*)(ws + OFF_HIDC), p.cmp_b1});
  }
  if (ph_lo <= 8 && 8 + 1 < ph_hi) xcd_barrier(gb);
  if (((PHSEL >> 9) & 1u) && ph_lo <= 9 && 9 < ph_hi) {
        for (int i = blockIdx.x * 256 + threadIdx.x; i < 32 * 64; i += gridDim.x * 256) { const int bg = i >> 6, d = i & 63; ((u16*)(ws + OFF_KC))[((size_t)bg * 256 + 255) * 64 + d] = 0; ((u16*)(ws + OFF_VCT))[((size_t)bg * 64 + d) * 256 + 255] = 0; }
        gemm_run(lds, 64, 1, 256, (const u16*)(ws + WT_C2), ALPlain{(const u16*)(ws + OFF_HIDC), 256}, EpiCmp2<0>{(u16*)(ws + OFF_KC), p.k_gain});
        gemm_run(lds, 64, 1, 256, (const u16*)(ws + WT_C2) + 128 * 256, ALPlain{(const u16*)(ws + OFF_HIDC) + 8192 * 256, 256}, EpiCmp2<1>{(u16*)(ws + OFF_VCT), nullptr});
  }
  if (ph_lo <= 9 && 9 + 1 < ph_hi) xcd_barrier(gb);
  if (((PHSEL >> 10) & 1u) && ph_lo <= 10 && 10 < ph_hi) { attn_phase(p, lds); }
  if (ph_lo <= 10 && 10 + 1 < ph_hi) xcd_barrier(gb);
  if (((PHSEL >> 11) & 1u) && ph_lo <= 11 && 11 < ph_hi) { gemm_dma(lds, 128, 8, 1024, (const u16*)(ws + OFF_Y), 1024, (const u16*)(ws + WT_NOUT), EpiResid{p.out, p.out}); }
  if (ph_lo <= 11 && 11 + 1 < ph_hi) xcd_barrier(gb);
}

extern "C" void kernel_launch(void* const* d_in, const int* in_sizes, int n_in, void* d_out, int out_size, void* d_ws, size_t ws_size, hipStream_t stream) {
  Params p{};
  const float** pp = (const float**)&p;
  for (int i = 0; i < 24; ++i) pp[i] = (const float*)d_in[i];
  p.out = (float*)d_out; p.ws = (char*)d_ws;
  static int grid_blocks = 0;
  if (!grid_blocks) {
    int dev = 0, cus = 0, per_cu = 0;
    hipGetDevice(&dev);
    hipDeviceGetAttribute(&cus, hipDeviceAttributeMultiprocessorCount, dev);
    hipOccupancyMaxActiveBlocksPerMultiprocessor(&per_cu, mega, 256, 0);
    if (per_cu > 2) per_cu = 2;
    if (per_cu < 1) per_cu = 1;
    grid_blocks = cus * per_cu;
  }
#if MULTI_LAUNCH
  for (int ph = 0; ph < NPHASE; ++ph) {
    hipLaunchKernelGGL(mega, dim3(grid_blocks), dim3(256), 0, stream, p, ph, ph + 1);
#ifdef DUP_MASK
    if ((DUP_MASK >> ph) & 1) hipLaunchKernelGGL(mega, dim3(grid_blocks), dim3(256), 0, stream, p, ph, ph + 1);
#endif
  }
#else
  hipMemsetAsync((char*)d_ws + OFF_BAR, 0, (4096 + 2048 + 64) * 4, stream);
  int lo = 0, hi = NPHASE;
  void* args[] = {&p, &lo, &hi};
  hipError_t e = hipLaunchCooperativeKernel((void*)mega, dim3(grid_blocks), dim3(256), args, 0, stream);
  if (e != hipSuccess) fprintf(stderr, "cooperative launch failed: %s (grid %d)\n", hipGetErrorString(e), grid_blocks);
#endif
}
```

```cpp
#include <hip/hip_runtime.h>
#include <hip/hip_cooperative_groups.h>
#include <cstdio>
#include <cstdint>
namespace cg = cooperative_groups;

#ifndef MULTI_LAUNCH
#define MULTI_LAUNCH 0
#endif

#define DEVI __device__ __forceinline__
typedef unsigned short u16;
typedef unsigned long long u64;
typedef short bf16x8 __attribute__((ext_vector_type(8)));
typedef float f32x16 __attribute__((ext_vector_type(16)));
typedef float f32x4 __attribute__((ext_vector_type(4)));
typedef unsigned u32x4 __attribute__((ext_vector_type(4)));
typedef unsigned u32x2 __attribute__((ext_vector_type(2)));
typedef _Float16 h8 __attribute__((ext_vector_type(8)));
typedef _Float16 h4 __attribute__((ext_vector_type(4)));

constexpr int NT = 32768, SEQ = 4096, DM = 1024;
constexpr size_t MiB = 1u << 20;
constexpr size_t WT_IN = 0, WT_L1 = 8 * MiB, WT_W2 = 8 * MiB + 512 * 1024, WT_A2 = WT_W2 + 128 * 1024, WT_OUT = 9 * MiB,
                 WT_NIN = 11 * MiB, WT_C1 = 19 * MiB, WT_C2 = 21 * MiB, WT_NOUT = 22 * MiB;
constexpr size_t OFF_H = 32 * MiB, OFF_R = 96 * MiB, OFF_K = 160 * MiB, OFF_V = 224 * MiB, OFF_Z = 288 * MiB, OFF_HID = 352 * MiB,
                 OFF_Y = 360 * MiB, OFF_O = 424 * MiB;
constexpr size_t OFF_Q = OFF_R, OFF_ZS = OFF_Z, OFF_KCR = 160 * MiB, OFF_VCR = 176 * MiB, OFF_KS = 192 * MiB, OFF_VST = 208 * MiB,
                 OFF_KW = 224 * MiB, OFF_VWT = 240 * MiB, OFF_G = OFF_HID, OFF_HIDC = 424 * MiB, OFF_KC = 432 * MiB, OFF_VCT = 433 * MiB;

constexpr size_t OFF_BAR = 500 * MiB;
DEVI unsigned xcc_id_() { return (unsigned)__builtin_amdgcn_s_getreg((3 << 11) | 20) & 0xFu; }
struct Params {
  const float *x, *norm_g, *mu, *w_in, *w0, *w1, *w2, *a0, *a1, *a2, *k_k, *k_a, *r_k, *lnx_g, *lnx_b, *w_out;
  const float *n_w_in, *q_gain, *k_gain, *cmp_pe, *cmp_w1, *cmp_b1, *cmp_w2, *n_w_out;
  float* out; char* ws;
};

typedef __bf16 bf2_t __attribute__((ext_vector_type(2)));
typedef float f32x2 __attribute__((ext_vector_type(2)));
DEVI unsigned cvt_pk_bf16(float lo, float hi) { f32x2 v = {lo, hi}; bf2_t r = __builtin_convertvector(v, bf2_t); return __builtin_bit_cast(unsigned, r); }
DEVI float bflo(unsigned u) { return __uint_as_float(u << 16); }
DEVI float bfhi(unsigned u) { return __uint_as_float(u & 0xffff0000u); }
DEVI float sigmoidf_(float x) { return __builtin_amdgcn_rcpf(1.f + __expf(-x)); }
DEVI float siluf_(float x) { return x * __builtin_amdgcn_rcpf(1.f + __expf(-x)); }
DEVI float tanhf_(float x) { float e = __expf(-2.f * fabsf(x)); float t = (1.f - e) * __builtin_amdgcn_rcpf(1.f + e); return x < 0 ? -t : t; }
template <int CTRL> DEVI float dppf(float x) { return __builtin_bit_cast(float, __builtin_amdgcn_mov_dpp(__builtin_bit_cast(int, x), CTRL, 0xf, 0xf, true)); }
DEVI float allred16(float x) { x += dppf<0xB1>(x); x += dppf<0x4E>(x); x += dppf<0x141>(x); x += dppf<0x140>(x); return x; }
DEVI float quadsum(float x) { x += dppf<0xB1>(x); x += dppf<0x4E>(x); return x; }
DEVI int lds_off(int row, int c) { return row * 128 + ((c ^ ((row >> 1) & 7)) << 4); }

DEVI void cvt_job(char* lds, const float* __restrict__ src, int K, int N, int Npad, u16* __restrict__ dst, int ldd) {
  float* t = (float*)lds;
  const int tid = threadIdx.x;
  const int tk = K >> 6, tn = Npad >> 6;
  for (int tile = blockIdx.x; tile < tk * tn; tile += gridDim.x) {
    const int k0 = (tile % tk) << 6, n0 = (tile / tk) << 6;
#pragma unroll
    for (int i = 0; i < 16; ++i) {
      const int k = i * 4 + (tid >> 6), n = tid & 63;
      t[k * 65 + n] = (n0 + n < N) ? src[(size_t)(k0 + k) * N + n0 + n] : 0.f;
    }
    __syncthreads();
#pragma unroll
    for (int i = 0; i < 8; ++i) {
      const int n = i * 8 + (tid >> 5), kk = (tid & 31) * 2;
      *(unsigned*)(dst + (size_t)(n0 + n) * ldd + k0 + kk) = cvt_pk_bf16(t[kk * 65 + n], t[(kk + 1) * 65 + n]);
    }
    __syncthreads();
  }
}
DEVI void zero_job(u16* dst, int rows, int cols, int ldd) {
  const int cpr = cols >> 3;
  for (int i = blockIdx.x * 256 + threadIdx.x; i < rows * cpr; i += gridDim.x * 256) {
    const int r = i / cpr, c = i - r * cpr;
    *(u32x4*)(dst + (size_t)r * ldd + c * 8) = (u32x4){0, 0, 0, 0};
  }
}
DEVI void rmsnorm_phase(const float* __restrict__ X, const float* __restrict__ g, u16* __restrict__ H) {
  const int lane = threadIdx.x & 63, gw = blockIdx.x * 4 + (threadIdx.x >> 6), nw = gridDim.x * 4;
  f32x4 gv[4];
#pragma unroll
  for (int i = 0; i < 4; ++i) gv[i] = *(const f32x4*)(g + i * 256 + lane * 4);
  for (int row = gw; row < NT; row += nw) {
    f32x4 v[4]; float ss = 0.f;
#pragma unroll
    for (int i = 0; i < 4; ++i) { v[i] = *(const f32x4*)(X + (size_t)row * 1024 + i * 256 + lane * 4); ss += v[i][0] * v[i][0] + v[i][1] * v[i][1] + v[i][2] * v[i][2] + v[i][3] * v[i][3]; }
#pragma unroll
    for (int o = 1; o < 64; o <<= 1) ss += __shfl_xor(ss, o);
    const float rinv = rsqrtf(ss * (1.f / 1024.f) + 1e-6f);
#pragma unroll
    for (int i = 0; i < 4; ++i) {
      u32x2 w; w.x = cvt_pk_bf16(v[i][0] * rinv * gv[i][0], v[i][1] * rinv * gv[i][1]); w.y = cvt_pk_bf16(v[i][2] * rinv * gv[i][2], v[i][3] * rinv * gv[i][3]);
      *(u32x2*)(H + (size_t)row * 1024 + i * 256 + lane * 4) = w;
    }
  }
}

struct ALPlain {
  static constexpr int DEPTH = 2; static constexpr int NLD = 4;
  const u16* A; int lda;
  DEVI void setup(int, int) {}
  static DEVI int row(int lr, int i) { return lr + 32 * i; }
  DEVI void load(u32x4 (&r)[4], int row0, int kc) const {
#pragma unroll
    for (int i = 0; i < 4; ++i) r[i] = *(const u32x4*)(A + (size_t)(row0 + 32 * i) * lda + kc);
  }
};
struct ALMix {
  static constexpr int DEPTH = 2; static constexpr int NLD = 6;
  const u16* H; const float* mu; int mode; int c;
  DEVI void setup(int, int tn) { c = mode == 1 ? 4 + tn : (tn >> 3); }
  static DEVI int row(int lr, int i) { return lr * 4 + i; }
  DEVI void load(u32x4 (&r)[4], int row0, int kc) const {
    const int kk = kc; const float* m = mu + c * 1024;
    const f32x4 m0 = *(const f32x4*)(m + kk), m1 = *(const f32x4*)(m + kk + 4);
    const int lr = row0 & 31, rowb = (row0 - lr) + lr * 4;
    u32x4 hc[4];
#pragma unroll
    for (int i = 0; i < 4; ++i) hc[i] = *(const u32x4*)(H + (size_t)(rowb + i) * 1024 + kk);
    u32x4 hp = (u32x4){0, 0, 0, 0};
    if (rowb & (SEQ - 1)) hp = *(const u32x4*)(H + (size_t)(rowb - 1) * 1024 + kk);
#pragma unroll
    for (int i = 0; i < 4; ++i) {
      const u32x4 pv = i == 0 ? hp : hc[i > 0 ? i - 1 : 0];
      u32x4 o;
#pragma unroll
      for (int e = 0; e < 4; ++e) {
        const f32x2 c2 = {bflo(hc[i][e]), bfhi(hc[i][e])}, p2 = {bflo(pv[e]), bfhi(pv[e])};
        const f32x2 mm = {e < 2 ? m0[2 * e] : m1[2 * e - 4], e < 2 ? m0[2 * e + 1] : m1[2 * e - 3]};
        const f32x2 o2 = (p2 - c2) * mm + c2;
        o[e] = cvt_pk_bf16(o2.x, o2.y);
      }
      r[i] = o;
    }
  }
};
struct ALCmp {
  static constexpr int DEPTH = 2; static constexpr int NLD = 6;
  const u16* rawk; const u16* rawv; const float* pe0; const u16* raw; const float* pe;
  DEVI void setup(int, int tn) { raw = (tn >> 1) ? rawv : rawk; pe = pe0 + (tn >> 1) * 2048; }
  static DEVI int row(int lr, int i) { return lr + 32 * i; }
  DEVI void load(u32x4 (&r)[4], int row0, int kc) const {
    const f32x4 p0 = *(const f32x4*)(pe + kc), p1 = *(const f32x4*)(pe + kc + 4);
#pragma unroll
    for (int i = 0; i < 4; ++i) {
      int row = row0 + 32 * i; row = row > 8159 ? 8159 : row;
      const int bg = row / 255, n = row - bg * 255;
      const u32x4 v = *(const u32x4*)(raw + ((size_t)bg * SEQ + n * 16) * 64 + kc);
      u32x4 o;
      o[0] = cvt_pk_bf16(bflo(v[0]) + p0[0], bfhi(v[0]) + p0[1]); o[1] = cvt_pk_bf16(bflo(v[1]) + p0[2], bfhi(v[1]) + p0[3]);
      o[2] = cvt_pk_bf16(bflo(v[2]) + p1[0], bfhi(v[2]) + p1[1]); o[3] = cvt_pk_bf16(bflo(v[3]) + p1[2], bfhi(v[3]) + p1[3]);
      r[i] = o;
    }
  }
};

template <class AL, class EP>
DEVI void gemm_run(char* lds, int Mt, int Nt, int K, const u16* __restrict__ Bt, AL al, const EP ep) {
  const int tid = threadIdx.x, wave = tid >> 6, lane = tid & 63, wm = wave >> 1, wn = wave & 1;
  const int lc = tid & 7, lr = tid >> 3, col = lane & 31, hh = lane >> 5;
  const int nk = K >> 6;
#define GBAR() do { asm volatile("s_waitcnt lgkmcnt(0)" ::: "memory"); __builtin_amdgcn_s_barrier(); asm volatile("" ::: "memory"); } while (0)
  constexpr int NS = AL::DEPTH;
  if (*(const unsigned*)(lds + 74240)) __builtin_amdgcn_s_sleep(20);
  const bool xsw = ((gridDim.x & 7) == 0) && ((Mt & 63) == 0);
  const int xcd = blockIdx.x & 7, nloc = gridDim.x >> 3, Mx = Mt >> 3;
  const int t_first = xsw ? (int)(blockIdx.x >> 3) : (int)blockIdx.x, t_step = xsw ? nloc : (int)gridDim.x, t_end = xsw ? Mx * Nt : Mt * Nt;
  for (int tile = t_first; tile < t_end; tile += t_step) {
    int tm, tn;
    if (xsw) { const int g = tile / (8 * Nt), within = tile - g * (8 * Nt); tn = within >> 3; tm = xcd * Mx + g * 8 + (within & 7); }
    else { tm = tile / Nt; tn = tile - tm * Nt; }
    al.setup(tm, tn);
    f32x16 acc[2][2];
#pragma unroll
    for (int a = 0; a < 2; ++a)
#pragma unroll
      for (int b = 0; b < 2; ++b)
#pragma unroll
        for (int i = 0; i < 16; ++i) acc[a][b][i] = 0.f;
    u32x4 ra[NS][4], rb[NS][4];
    const u16* bp = Bt + (size_t)(tn * 128 + lr) * K + lc * 8;
#define G_LOAD(set, kt_) do { al.load(ra[set], tm * 128 + lr, (kt_) * 64 + lc * 8); _Pragma("unroll") for (int i = 0; i < 4; ++i) rb[set][i] = *(const u32x4*)(bp + (size_t)i * 32 * K + (kt_) * 64); } while (0)
#define G_STORE(set, st_) do { char* da = lds + (st_) * 32768; _Pragma("unroll") for (int i = 0; i < 4; ++i) { *(u32x4*)(da + lds_off(AL::row(lr, i), lc)) = ra[set][i]; *(u32x4*)(da + 16384 + lds_off(lr + 32 * i, lc)) = rb[set][i]; } } while (0)
#define G_COMPUTE(st_) do { const char* sa = lds + (st_) * 32768; const char* sb = sa + 16384; \
      _Pragma("unroll") for (int ks = 0; ks < 4; ++ks) { bf16x8 af[2], bfr[2]; \
        _Pragma("unroll") for (int mi = 0; mi < 2; ++mi) af[mi] = *(const bf16x8*)(sa + lds_off(wm * 64 + mi * 32 + col, ks * 2 + hh)); \
        _Pragma("unroll") for (int ni = 0; ni < 2; ++ni) bfr[ni] = *(const bf16x8*)(sb + lds_off(wn * 64 + ni * 32 + col, ks * 2 + hh)); \
        _Pragma("unroll") for (int mi = 0; mi < 2; ++mi) _Pragma("unroll") for (int ni = 0; ni < 2; ++ni) acc[mi][ni] = __builtin_amdgcn_mfma_f32_32x32x16_bf16(bfr[ni], af[mi], acc[mi][ni], 0, 0, 0); } } while (0)
    if constexpr (NS == 1) {
      G_LOAD(0, 0); G_STORE(0, 0);
      GBAR();
      for (int kt = 0; kt < nk; ++kt) {
        const int st = kt & 1;
        if (kt + 1 < nk) G_LOAD(0, kt + 1);
        G_COMPUTE(st);
        if (kt + 1 < nk) G_STORE(0, st ^ 1);
        GBAR();
      }
    } else if (nk & 1) {
      G_LOAD(0, 0); G_STORE(0, 0);
      GBAR();
      for (int kt = 0; kt < nk; ++kt) {
        const int st = kt & 1;
        if (kt + 1 < nk) G_LOAD(0, kt + 1);
        G_COMPUTE(st);
        if (kt + 1 < nk) G_STORE(0, st ^ 1);
        GBAR();
      }
    } else {
      const int wv_ = __builtin_amdgcn_readfirstlane(tid >> 6);
      const unsigned lbase_ = (unsigned)(size_t)(__attribute__((address_space(3))) char*)lds;
      unsigned bo_[4];
#pragma unroll
      for (int q = 0; q < 4; ++q) { const int row = (q * 4 + wv_) * 8 + (lane >> 3), c = (lane & 7) ^ ((row >> 1) & 7); bo_[q] = (unsigned)(((tn * 128 + row) * K + c * 8) * 2); }
#define B_DMA(kt_, st_) do { _Pragma("unroll") for (int q = 0; q < 4; ++q) { \
        const unsigned la_ = (unsigned)__builtin_amdgcn_readfirstlane((int)(lbase_ + (st_) * 32768 + 16384 + (q * 4 + wv_) * 1024)); \
        const char* gp_ = (const char*)Bt + bo_[q] + (size_t)(kt_) * 128; \
        asm volatile("s_mov_b32 m0, %0\n\tglobal_load_lds_dwordx4 %1, off" :: "s"(la_), "v"(gp_) : "memory", "m0"); } } while (0)
#define A_LOAD(set, kt_) al.load(ra[set], tm * 128 + lr, (kt_) * 64 + lc * 8)
#define A_STORE(set, st_) do { char* da = lds + (st_) * 32768; _Pragma("unroll") for (int i = 0; i < 4; ++i) *(u32x4*)(da + lds_off(AL::row(lr, i), lc)) = ra[set][i]; } while (0)
#define VM_WAIT_A() do { if constexpr (AL::NLD == 4) asm volatile("s_waitcnt vmcnt(4)" ::: "memory"); else asm volatile("s_waitcnt vmcnt(6)" ::: "memory"); } while (0)
      A_LOAD(0, 0);
      A_LOAD(1, 1);
      B_DMA(0, 0);
      A_STORE(0, 0);
      asm volatile("s_waitcnt vmcnt(0)" ::: "memory");
      GBAR();
      for (int kt = 0; kt < nk - 2; kt += 2) {
        B_DMA(kt + 1, 1);
        A_LOAD(0, kt + 2);
        G_COMPUTE(0);
        A_STORE(1, 1);
        VM_WAIT_A();
        GBAR();
        B_DMA(kt + 2, 0);
        A_LOAD(1, kt + 3);
        G_COMPUTE(1);
        A_STORE(0, 0);
        VM_WAIT_A();
        GBAR();
      }
      B_DMA(nk - 1, 1);
      G_COMPUTE(0);
      A_STORE(1, 1);
      asm volatile("s_waitcnt vmcnt(0)" ::: "memory");
      GBAR();
      G_COMPUTE(1);
      GBAR();
#undef B_DMA
#undef A_LOAD
#undef A_STORE
#undef VM_WAIT_A
    }
#undef G_LOAD
#undef G_STORE
#undef G_COMPUTE
#undef GBAR
    ep(acc, tm * 128 + wm * 64 + col, tn * 128 + wn * 64, hh);
  }
}
#define LDS3 __attribute__((address_space(3)))
DEVI int lds_off32(int row, int c) { return row * 64 + ((c ^ ((row >> 2) & 3)) << 4); }
template <class EP>
DEVI void gemm_dma(char* lds, int Mt, int Nt, int K, const u16* __restrict__ A, int lda, const u16* __restrict__ Bt, const EP ep) {
  const int tid = threadIdx.x, wave = __builtin_amdgcn_readfirstlane(tid >> 6), lane = tid & 63, wm = wave >> 1, wn = wave & 1;
  const int col = lane & 31, hh = lane >> 5;
  const int nk = K >> 5;
  if (*(const unsigned*)(lds + 74240)) __builtin_amdgcn_s_sleep(20);
  const bool xsw = ((gridDim.x & 7) == 0) && ((Mt & 63) == 0);
  const int xcd = blockIdx.x & 7, nloc = gridDim.x >> 3, Mx = Mt >> 3;
  const int t_first = xsw ? (int)(blockIdx.x >> 3) : (int)blockIdx.x, t_step = xsw ? nloc : (int)gridDim.x, t_end = xsw ? Mx * Nt : Mt * Nt;
  const unsigned lds_base = (unsigned)(size_t)(LDS3 char*)lds;
  for (int tile = t_first; tile < t_end; tile += t_step) {
    int tm, tn;
    if (xsw) { const int g = tile / (8 * Nt), within = tile - g * (8 * Nt); tn = within >> 3; tm = xcd * Mx + g * 8 + (within & 7); }
    else { tm = tile / Nt; tn = tile - tm * Nt; }
    f32x16 acc[4][2];
#pragma unroll
    for (int a = 0; a < 4; ++a)
#pragma unroll
      for (int b = 0; b < 2; ++b)
#pragma unroll
        for (int i = 0; i < 16; ++i) acc[a][b][i] = 0.f;
    unsigned aoff[4], boff[2];
#pragma unroll
    for (int q = 0; q < 4; ++q) { const int row = (q * 4 + wave) * 16 + (lane >> 2), c = (lane & 3) ^ ((row >> 2) & 3);
      aoff[q] = (unsigned)(((tm * 256 + row) * lda + c * 8) * 2); if (q < 2) boff[q] = (unsigned)(((tn * 128 + row) * K + c * 8) * 2); }
#define D_ISSUE(gp_, la_) asm volatile("s_mov_b32 m0, %0\n\tglobal_load_lds_dwordx4 %1, off" :: "s"(la_), "v"(gp_) : "memory", "m0")
#define D_STAGE(kt_, st_) do { _Pragma("unroll") for (int q = 0; q < 4; ++q) { \
      const unsigned la_ = (unsigned)__builtin_amdgcn_readfirstlane((int)(lds_base + (st_) * 24576 + (q * 4 + wave) * 1024)); \
      const char* ga_ = (const char*)A + aoff[q] + (size_t)(kt_) * 64; D_ISSUE(ga_, la_); \
      if (q < 2) { const char* gb_ = (const char*)Bt + boff[q] + (size_t)(kt_) * 64; const unsigned lb_ = la_ + 16384u; D_ISSUE(gb_, lb_); } } } while (0)
    D_STAGE(0, 0); D_STAGE(1, 1);
    int st = 0;
    for (int kt = 0; kt < nk; ++kt) {
      if (kt + 1 < nk) asm volatile("s_waitcnt vmcnt(6)" ::: "memory"); else asm volatile("s_waitcnt vmcnt(0)" ::: "memory");
      __builtin_amdgcn_s_barrier(); asm volatile("" ::: "memory");
      const int st2 = st == 0 ? 2 : st - 1;
      if (kt + 2 < nk) D_STAGE(kt + 2, st2);
      const char* sa = lds + st * 24576; const char* sb = sa + 16384;
#pragma unroll
      for (int ks = 0; ks < 2; ++ks) {
        bf16x8 af[4], bfr[2];
#pragma unroll
        for (int mi = 0; mi < 4; ++mi) af[mi] = *(const bf16x8*)(sa + lds_off32(wm * 128 + mi * 32 + col, ks * 2 + hh));
#pragma unroll
        for (int ni = 0; ni < 2; ++ni) bfr[ni] = *(const bf16x8*)(sb + lds_off32(wn * 64 + ni * 32 + col, ks * 2 + hh));
#pragma unroll
        for (int mi = 0; mi < 4; ++mi)
#pragma unroll
          for (int ni = 0; ni < 2; ++ni) acc[mi][ni] = __builtin_amdgcn_mfma_f32_32x32x16_bf16(bfr[ni], af[mi], acc[mi][ni], 0, 0, 0);
      }
      asm volatile("s_waitcnt lgkmcnt(0)" ::: "memory");
      st = st == 2 ? 0 : st + 1;
    }
    __builtin_amdgcn_s_barrier(); asm volatile("" ::: "memory");
#undef D_STAGE
#undef D_ISSUE
    ep(acc, tm * 256 + wm * 128 + col, tn * 128 + wn * 64, hh);
  }
}
#define EPI_LOOP for (int mi = 0; mi < 2; ++mi) for (int ni = 0; ni < 2; ++ni) for (int rr = 0; rr < 4; ++rr)

struct EpiRwkvProj {
  _Float16 *R, *K, *V, *Z;
  DEVI void operator()(const f32x16 (&acc)[2][2], int m0, int nb, int hh) const {
    const int c = nb >> 10; _Float16* dst = c == 0 ? R : c == 1 ? K : c == 2 ? V : Z; const int n0 = (nb & 1023) + 4 * hh;
#pragma unroll
    EPI_LOOP { h4 v; for (int e = 0; e < 4; ++e) v[e] = (_Float16)acc[mi][ni][rr * 4 + e];
      *(h4*)(dst + (size_t)(m0 + mi * 32) * 1024 + n0 + ni * 32 + rr * 8) = v; }
  }
};
struct EpiL1 {
  u16* HID;
  DEVI void operator()(const f32x16 (&acc)[2][2], int m0, int nb, int hh) const {
    if (nb == 64 || nb == 128) return;
    const int cb = nb ? 64 : 0;
#pragma unroll
    EPI_LOOP { float v[4]; for (int e = 0; e < 4; ++e) { float x = acc[mi][ni][rr * 4 + e]; v[e] = nb == 0 ? tanhf_(x) : x; }
      u32x2 w; w.x = cvt_pk_bf16(v[0], v[1]); w.y = cvt_pk_bf16(v[2], v[3]);
      *(u32x2*)(HID + (size_t)(m0 + mi * 32) * 128 + cb + 4 * hh + ni * 32 + rr * 8) = w; }
  }
};
template <int MODE> struct EpiL2 {
  _Float16* D; const float* bias;
  DEVI void operator()(const f32x16 (&acc)[2][2], int m0, int nb, int hh) const {
#pragma unroll
    EPI_LOOP { const int n = nb + 4 * hh + ni * 32 + rr * 8; const f32x4 bv = *(const f32x4*)(bias + n); h4 v;
      for (int e = 0; e < 4; ++e) { const float u = bv[e] + acc[mi][ni][rr * 4 + e]; float o;
        if (MODE == 0) o = __expf(-0.6065306597126334f * sigmoidf_(u));   else o = sigmoidf_(u);
        v[e] = (_Float16)o; }
      *(h4*)(D + (size_t)(m0 + mi * 32) * 1024 + n) = v; }
  }
};
struct EpiResid {
  const float* resid; float* out;
  template <int MI> DEVI void operator()(const f32x16 (&acc)[MI][2], int m0, int nb, int hh) const {
#pragma unroll
    for (int mi = 0; mi < MI; ++mi) for (int ni = 0; ni < 2; ++ni) for (int rr = 0; rr < 4; ++rr) { const size_t o = (size_t)(m0 + mi * 32) * 1024 + nb + 4 * hh + ni * 32 + rr * 8; f32x4 v = *(const f32x4*)(resid + o);
      for (int e = 0; e < 4; ++e) v[e] += acc[mi][ni][rr * 4 + e];
      *(f32x4*)(out + o) = v; }
  }
};
struct EpiNsaIn {
  char* ws; const float *q_gain, *k_gain; int nb0;
  template <int MI> DEVI void operator()(const f32x16 (&acc)[MI][2], int m0, int nb_, int hh) const {
    const int nb = nb_ + nb0;
    if (nb >= 3632) return;
    int kind; const float* gain = nullptr; float post = 1.f;
    u16* dst = nullptr; int gi = 0; bool norm = false;
    if (nb < 1024) { kind = 0; norm = true; gain = q_gain; post = 0.125f; }
    else if (nb < 2560) { const int seg = (nb - 1024) >> 8; gi = ((nb - 1024) >> 6) & 3;
      dst = (u16*)(ws + (seg == 0 ? OFF_KCR : seg == 1 ? OFF_VCR : seg == 2 ? OFF_KS : seg == 3 ? OFF_VST : seg == 4 ? OFF_KW : OFF_VWT));
      kind = (seg == 3 || seg == 5) ? 2 : 1; if (seg == 2) { norm = true; gain = k_gain + 64; } if (seg == 4) { norm = true; gain = k_gain + 128; } }
    else if (nb < 3584) kind = 3; else kind = 4;
#pragma unroll
    for (int mi = 0; mi < MI; ++mi) {
      const int m = m0 + mi * 32;
      float rinv = 1.f;
      if (norm) { float ss = 0.f;
#pragma unroll
        for (int ni = 0; ni < 2; ++ni)
#pragma unroll
          for (int i = 0; i < 16; ++i) ss += acc[mi][ni][i] * acc[mi][ni][i];
        ss += __shfl_xor(ss, 32); rinv = rsqrtf(ss * (1.f / 64.f) + 1e-6f) * post; }
#pragma unroll
      for (int ni = 0; ni < 2; ++ni)
#pragma unroll
        for (int rr = 0; rr < 4; ++rr) {
          const int d = 4 * hh + ni * 32 + rr * 8;
          float v[4];
#pragma unroll
          for (int e = 0; e < 4; ++e) v[e] = acc[mi][ni][rr * 4 + e];
          if (norm) { const f32x4 gv = *(const f32x4*)(gain + d);
#pragma unroll
            for (int e = 0; e < 4; ++e) v[e] *= rinv * gv[e]; }
          if (kind == 0) { u32x2 w; w.x = cvt_pk_bf16(v[0], v[1]); w.y = cvt_pk_bf16(v[2], v[3]); *(u32x2*)((u16*)(ws + OFF_Q) + (size_t)m * 1024 + nb + d) = w; }
          else if (kind == 1) { const int b = m >> 12, t = m & 4095; u32x2 w; w.x = cvt_pk_bf16(v[0], v[1]); w.y = cvt_pk_bf16(v[2], v[3]);
            *(u32x2*)(dst + (((size_t)(b * 4 + gi) * SEQ + t) << 6) + d) = w; }
          else if (kind == 2) { const int b = m >> 12, t = m & 4095;
#pragma unroll
            for (int e = 0; e < 4; ++e) dst[((size_t)(b * 4 + gi) * 64 + d + e) * SEQ + t] = (u16)(cvt_pk_bf16(v[e], 0.f) & 0xffff); }
          else if (kind == 3) { u32x2 w; w.x = cvt_pk_bf16(siluf_(v[0]), siluf_(v[1])); w.y = cvt_pk_bf16(siluf_(v[2]), siluf_(v[3]));
            *(u32x2*)((u16*)(ws + OFF_ZS) + (size_t)m * 1024 + (nb - 2560) + d) = w; }
          else { if (d < 48) { f32x4 o; for (int e = 0; e < 4; ++e) o[e] = sigmoidf_(v[e]); *(f32x4*)((float*)(ws + OFF_G) + (size_t)m * 48 + d) = o; } }
        }
    }
  }
};
struct EpiCmp1 {
  u16* HID; const float* b1;
  DEVI void operator()(const f32x16 (&acc)[2][2], int m0, int nb, int hh) const {
    const int which = nb >> 8; u16* Hd = HID + (size_t)which * 8192 * 256;
#pragma unroll
    EPI_LOOP { const int n = nb + 4 * hh + ni * 32 + rr * 8; const f32x4 bv = *(const f32x4*)(b1 + n); float v[4];
      for (int e = 0; e < 4; ++e) { const float x = acc[mi][ni][rr * 4 + e] + bv[e]; v[e] = 0.5f * x * (1.f + tanhf_(0.7978845608028654f * (x + 0.044715f * x * x * x))); }
      u32x2 w; w.x = cvt_pk_bf16(v[0], v[1]); w.y = cvt_pk_bf16(v[2], v[3]);
      *(u32x2*)(Hd + (size_t)(m0 + mi * 32) * 256 + (n & 255)) = w; }
  }
};
template <int WHICH> struct EpiCmp2 {
  u16* dst; const float* gain;
  DEVI void operator()(const f32x16 (&acc)[2][2], int m0, int nb, int hh) const {
    if (nb >= 64) return;
#pragma unroll
    for (int mi = 0; mi < 2; ++mi) {
      const int row = m0 + mi * 32; const int bg = row / 255, n = row - bg * 255;
      float rinv = 1.f;
      if (WHICH == 0) { float ss = 0.f;
#pragma unroll
        for (int ni = 0; ni < 2; ++ni)
#pragma unroll
          for (int i = 0; i < 16; ++i) ss += acc[mi][ni][i] * acc[mi][ni][i];
        ss += __shfl_xor(ss, 32); rinv = rsqrtf(ss * (1.f / 64.f) + 1e-6f); }
      if (row < 8160) {
#pragma unroll
        for (int ni = 0; ni < 2; ++ni)
#pragma unroll
          for (int rr = 0; rr < 4; ++rr) {
            const int d = 4 * hh + ni * 32 + rr * 8; float v[4];
#pragma unroll
            for (int e = 0; e < 4; ++e) v[e] = acc[mi][ni][rr * 4 + e];
            if (WHICH == 0) { const f32x4 gv = *(const f32x4*)(gain + d); u32x2 w; w.x = cvt_pk_bf16(v[0] * rinv * gv[0], v[1] * rinv * gv[1]); w.y = cvt_pk_bf16(v[2] * rinv * gv[2], v[3] * rinv * gv[3]);
              *(u32x2*)(dst + ((size_t)bg * 256 + n) * 64 + d) = w; }
            else {
#pragma unroll
              for (int e = 0; e < 4; ++e) dst[((size_t)bg * 64 + d + e) * 256 + n] = (u16)(cvt_pk_bf16(v[e], 0.f) & 0xffff); }
          }
      }
    }
  }
};

DEVI float allred8(float x) { x += dppf<0xB1>(x); x += dppf<0x4E>(x); x += dppf<0x141>(x); return x; }
DEVI void scan_phase(const Params& p, char* lds) {
  float* sR = (float*)lds;
  float* sV = sR + 5 * 2048;
  float* sP = sV + 1024;
  const _Float16* Rg = (const _Float16*)(p.ws + OFF_R); const _Float16* Kg = (const _Float16*)(p.ws + OFF_K); const _Float16* Vg = (const _Float16*)(p.ws + OFF_V);
  const _Float16* Wg = (const _Float16*)p.out; const _Float16* Ag = Wg + (size_t)NT * 1024;
  _Float16* Og = (_Float16*)(p.ws + OFF_O);
  const int tid = threadIdx.x, wave = tid >> 6, lane = tid & 63, rl = lane >> 3, sub = lane & 7, rowl = wave * 8 + rl;
  const int tt = tid >> 3, cc = tid & 7;
  for (int task = blockIdx.x; task < 256; task += gridDim.x) {
    const int bh = task >> 1, half = task & 1, b = bh >> 4, h = bh & 15;
    float kkc[8], kac[8], rkc[8];
#pragma unroll
    for (int i = 0; i < 8; ++i) { kkc[i] = p.k_k[h * 64 + cc * 8 + i]; kac[i] = p.k_a[h * 64 + cc * 8 + i]; rkc[i] = p.r_k[h * 64 + cc * 8 + i]; }
    float* BON = (float*)(p.ws + OFF_HID);
    size_t gb = ((size_t)b * SEQ + tt) * 1024 + h * 64 + cc * 8;
    h8 pr = *(const h8*)(Rg + gb), pk = *(const h8*)(Kg + gb), pv = *(const h8*)(Vg + gb), pw = *(const h8*)(Wg + gb), pa = *(const h8*)(Ag + gb);
    f32x2 S0 = {0.f, 0.f}, S1 = {0.f, 0.f}, S2 = {0.f, 0.f}, S3 = {0.f, 0.f};
    for (int c = 0; c < 128; ++c) {
      {
        float kf[8], af[8], kk[8]; float ss = 0.f;
#pragma unroll
        for (int i = 0; i < 8; ++i) { kf[i] = (float)pk[i]; af[i] = (float)pa[i]; kk[i] = kf[i] * kkc[i]; ss += kk[i] * kk[i]; }
        ss += __shfl_xor(ss, 1); ss += __shfl_xor(ss, 2); ss += __shfl_xor(ss, 4);
        const float inv = 1.f / fmaxf(sqrtf(ss), 1e-12f);
        const int o = tt * 64 + cc * 8;
        if (half == 0) {
          float bn = 0.f;
#pragma unroll
          for (int i = 0; i < 8; ++i) bn += (float)pr[i] * (kf[i] * (1.f + (af[i] - 1.f) * kac[i])) * rkc[i];
          bn += __shfl_xor(bn, 1); bn += __shfl_xor(bn, 2); bn += __shfl_xor(bn, 4);
          if (cc == 0) BON[((size_t)b * SEQ + c * 32 + tt) * 16 + h] = bn;
        }
        f32x4 v0, v1;
#define ST8(base, expr) do { for (int i = 0; i < 4; ++i) { { const int e = i; v0[i] = (expr); } { const int e = i + 4; v1[i] = (expr); } } *(f32x4*)((base) + o) = v0; *(f32x4*)((base) + o + 4) = v1; } while (0)
        ST8(sR, (float)pr[e]);
        ST8(sR + 2048, (float)pw[e]);
        ST8(sR + 4096, kf[e] * (1.f + (af[e] - 1.f) * kac[e]));
        ST8(sR + 6144, -(kk[e] * inv));
        ST8(sR + 8192, kk[e] * inv * af[e]);
#undef ST8
        if ((cc >> 2) == half) {
          for (int i = 0; i < 4; ++i) { v0[i] = (float)pv[i]; v1[i] = (float)pv[i + 4]; }
          *(f32x4*)(sV + tt * 32 + (cc & 3) * 8) = v0; *(f32x4*)(sV + tt * 32 + (cc & 3) * 8 + 4) = v1;
        }
      }
      __syncthreads();
      if (c + 1 < 128) { gb += (size_t)32 * 1024; pr = *(const h8*)(Rg + gb); pk = *(const h8*)(Kg + gb); pv = *(const h8*)(Vg + gb); pw = *(const h8*)(Wg + gb); pa = *(const h8*)(Ag + gb); }
      {
        const float* bR = sR + sub * 8; const float* bV = sV + rowl; float* bP = sP + rowl * 2 + (sub >> 2);
        f32x4 r0 = *(const f32x4*)(bR), r1 = *(const f32x4*)(bR + 4), w0 = *(const f32x4*)(bR + 2048), w1 = *(const f32x4*)(bR + 2052),
              k0 = *(const f32x4*)(bR + 4096), k1 = *(const f32x4*)(bR + 4100), n0 = *(const f32x4*)(bR + 6144), n1 = *(const f32x4*)(bR + 6148),
              a0 = *(const f32x4*)(bR + 8192), a1 = *(const f32x4*)(bR + 8196);
        float vv = bV[0];
#pragma unroll 2
        for (int t = 0; t < 32; ++t) {
          const int tn = t < 31 ? t + 1 : 31; const float* q = bR + tn * 64;
          const f32x4 r0n = *(const f32x4*)(q), r1n = *(const f32x4*)(q + 4), w0n = *(const f32x4*)(q + 2048), w1n = *(const f32x4*)(q + 2052),
                      k0n = *(const f32x4*)(q + 4096), k1n = *(const f32x4*)(q + 4100), n0n = *(const f32x4*)(q + 6144), n1n = *(const f32x4*)(q + 6148),
                      a0n = *(const f32x4*)(q + 8192), a1n = *(const f32x4*)(q + 8196);
          const float vvn = bV[tn * 32];
#define LO(x) ((f32x2){x[0], x[1]})
#define HI(x) ((f32x2){x[2], x[3]})
          const f32x2 vv2 = {vv, vv};
          f32x2 spa = S0 * LO(n0); spa = S1 * HI(n0) + spa;
          f32x2 spb = S2 * LO(n1); spb = S3 * HI(n1) + spb;
          const f32x2 sp = spa + spb;
          float sa = sp.x + sp.y;
          const f32x2 t0 = S0 * LO(w0) + vv2 * LO(k0), t1 = S1 * HI(w0) + vv2 * HI(k0), t2 = S2 * LO(w1) + vv2 * LO(k1), t3 = S3 * HI(w1) + vv2 * HI(k1);
          sa = allred8(sa);
          const f32x2 sa2 = {sa, sa};
          S0 = t0 + sa2 * LO(a0); S1 = t1 + sa2 * HI(a0); S2 = t2 + sa2 * LO(a1); S3 = t3 + sa2 * HI(a1);
          f32x2 oa = S0 * LO(r0); oa = S1 * HI(r0) + oa;
          f32x2 ob = S2 * LO(r1); ob = S3 * HI(r1) + ob;
          const f32x2 op = oa + ob;
          float o = op.x + op.y;
          o += dppf<0xB1>(o); o += dppf<0x4E>(o);
          bP[t * 64] = o;
#undef LO
#undef HI
          r0 = r0n; r1 = r1n; w0 = w0n; w1 = w1n; k0 = k0n; k1 = k1n; n0 = n0n; n1 = n1n; a0 = a0n; a1 = a1n; vv = vvn;
        }
      }
      __syncthreads();
      {
        const int t = tid >> 3, r4 = (tid & 7) * 4;
        const f32x4 q0 = *(const f32x4*)(sP + (t * 32 + r4) * 2), q1 = *(const f32x4*)(sP + (t * 32 + r4) * 2 + 4);
        h4 ov; ov[0] = (_Float16)(q0[0] + q0[1]); ov[1] = (_Float16)(q0[2] + q0[3]); ov[2] = (_Float16)(q1[0] + q1[1]); ov[3] = (_Float16)(q1[2] + q1[3]);
        *(h4*)(Og + ((size_t)b * SEQ + c * 32 + t) * 1024 + h * 64 + half * 32 + r4) = ov;
      }
    }
    __syncthreads();
  }
}
DEVI void post_phase(const Params& p) {
  const _Float16* Vg = (const _Float16*)(p.ws + OFF_V); const _Float16* Zg = (const _Float16*)(p.ws + OFF_Z); const _Float16* Og = (const _Float16*)(p.ws + OFF_O);
  const float* BON = (const float*)(p.ws + OFF_HID);
  u16* Y = (u16*)(p.ws + OFF_Y);
  for (int idx = blockIdx.x * 256 + threadIdx.x; idx < NT * 128; idx += gridDim.x * 256) {
    const int c8 = idx & 127; const size_t off = (size_t)(idx >> 7) * 1024 + c8 * 8; const int ch = c8 * 8;
    const h8 o = *(const h8*)(Og + off), v = *(const h8*)(Vg + off), z = *(const h8*)(Zg + off);
    const float bn = BON[(size_t)(idx >> 7) * 16 + (c8 >> 3)];
    float of[8]; float s = 0.f;
#pragma unroll
    for (int i = 0; i < 8; ++i) { of[i] = (float)o[i]; s += of[i]; }
    s += __shfl_xor(s, 1); s += __shfl_xor(s, 2); s += __shfl_xor(s, 4);
    const float mean = s * (1.f / 64.f); float q = 0.f;
#pragma unroll
    for (int i = 0; i < 8; ++i) { const float d = of[i] - mean; q += d * d; }
    q += __shfl_xor(q, 1); q += __shfl_xor(q, 2); q += __shfl_xor(q, 4);
    const float rstd = rsqrtf(q * (1.f / 64.f) + 64e-5f);
    float y[8];
#pragma unroll
    for (int i = 0; i < 8; ++i) { const float on = (of[i] - mean) * rstd * p.lnx_g[ch + i] + p.lnx_b[ch + i] + bn * (float)v[i]; y[i] = on * siluf_((float)z[i]); }
    u32x4 w; w[0] = cvt_pk_bf16(y[0], y[1]); w[1] = cvt_pk_bf16(y[2], y[3]); w[2] = cvt_pk_bf16(y[4], y[5]); w[3] = cvt_pk_bf16(y[6], y[7]);
    *(u32x4*)(Y + off) = w;
  }
}

constexpr float NEGINF = -__builtin_huge_valf();
constexpr float LOG2E = 1.4426950408889634f;
template <int MODE>
DEVI void attn_branch(char* lds, u64 tilemask, const u16* __restrict__ Kg, const u16* __restrict__ Vg, int vpitch, int lo, int hi, u64 selbits,
                      const bf16x8 (&qf)[4], const float m, float& l, f32x16 (&O)[2], float inv_l, float* imp_row) {
  if (!tilemask) return;
  const int tid = threadIdx.x, wave = __builtin_amdgcn_readfirstlane(tid >> 6), lane = tid & 63, col = lane & 31, hh = lane >> 5;
  const unsigned lds_base = (unsigned)(size_t)(LDS3 char*)lds;
  int koff[2], voff[2];
#pragma unroll
  for (int q = 0; q < 2; ++q) { const int row = (q * 4 + wave) * 8 + (lane >> 3), c = (lane & 7) ^ ((row >> 1) & 7); koff[q] = row * 64 + c * 8; voff[q] = row * vpitch + c * 8; }
#define A_DMA(gp_, la_) asm volatile("s_mov_b32 m0, %0\n\tglobal_load_lds_dwordx4 %1, off" :: "s"(la_), "v"(gp_) : "memory", "m0")
#define A_ISSUE(j_, st_) do { _Pragma("unroll") for (int q = 0; q < 2; ++q) { \
    const unsigned la_ = (unsigned)__builtin_amdgcn_readfirstlane((int)(lds_base + (st_) * 16384 + (q * 4 + wave) * 1024)); \
    const u16* gk_ = Kg + (size_t)(j_) * 4096 + koff[q]; A_DMA(gk_, la_); \
    const u16* gv_ = Vg + (size_t)(j_) * 64 + voff[q]; const unsigned lv_ = la_ + 8192u; A_DMA(gv_, lv_); } } while (0)
  int j = __builtin_ctzll(tilemask); tilemask &= tilemask - 1;
  int j1 = -1; if (tilemask) { j1 = __builtin_ctzll(tilemask); tilemask &= tilemask - 1; }
  A_ISSUE(j, 0);
  if (j1 >= 0) A_ISSUE(j1, 1);
  int st = 0; float carry = 0.f;
  while (true) {
    if (j1 >= 0) asm volatile("s_waitcnt vmcnt(4)" ::: "memory"); else asm volatile("s_waitcnt vmcnt(0)" ::: "memory");
    __builtin_amdgcn_s_barrier(); asm volatile("" ::: "memory");
    int j2 = -1;
    if (tilemask) { j2 = __builtin_ctzll(tilemask); tilemask &= tilemask - 1; const int st2 = st == 0 ? 2 : st - 1; A_ISSUE(j2, st2); }
    const char* kb = lds + st * 16384; const char* vb = kb + 8192;
    f32x16 s[2];
#pragma unroll
    for (int nt = 0; nt < 2; ++nt)
#pragma unroll
      for (int i = 0; i < 16; ++i) s[nt][i] = 0.f;
    bf16x8 kfr[4][2];
#pragma unroll
    for (int ks = 0; ks < 4; ++ks)
#pragma unroll
      for (int nt = 0; nt < 2; ++nt) kfr[ks][nt] = *(const bf16x8*)(kb + lds_off(nt * 32 + col, ks * 2 + hh));
    __builtin_amdgcn_sched_barrier(0);
#pragma unroll
    for (int ks = 0; ks < 4; ++ks)
#pragma unroll
      for (int nt = 0; nt < 2; ++nt) s[nt] = __builtin_amdgcn_mfma_f32_32x32x16_bf16(kfr[ks][nt], qf[ks], s[nt], 0, 0, 0);
    u32x2 vfr[2][2][2][2];
    if (MODE != 0) {
#pragma unroll
      for (int nt = 0; nt < 2; ++nt)
#pragma unroll
        for (int k2 = 0; k2 < 2; ++k2)
#pragma unroll
          for (int dt = 0; dt < 2; ++dt) { const int c0 = nt * 4 + 2 * k2, d = dt * 32 + col, sw = (d >> 1) & 7;
            vfr[nt][k2][dt][0] = *(const u32x2*)(vb + d * 128 + ((c0 ^ sw) << 4) + 8 * hh); vfr[nt][k2][dt][1] = *(const u32x2*)(vb + d * 128 + (((c0 + 1) ^ sw) << 4) + 8 * hh); }
      __builtin_amdgcn_sched_barrier(0);
    }
    const int k0 = j * 64; const bool flag = (selbits >> j) & 1;
    const bool finv = !flag || hi < k0 || lo > k0 + 63 || hi < lo;
    const bool full = !finv && lo <= k0 && hi >= k0 + 63;
    if (__builtin_amdgcn_ballot_w64(!finv && !full) != 0ull) {
      asm volatile("; boundary-mask path" ::: "memory");
      const unsigned span = (unsigned)(hi - lo); const int b0 = k0 + 4 * hh - lo;
#pragma unroll
      for (int nt = 0; nt < 2; ++nt)
#pragma unroll
        for (int i = 0; i < 16; ++i) if ((unsigned)(b0 + nt * 32 + (i & 3) + 8 * (i >> 2)) > span) s[nt][i] = NEGINF;
    }
    const float nb = finv ? NEGINF : (MODE == 2 ? inv_l : -m);
    f32x2 ps2 = {0.f, 0.f};
#pragma unroll
    for (int nt = 0; nt < 2; ++nt)
#pragma unroll
      for (int i = 0; i < 16; i += 2) {
        f32x2 x = {s[nt][i], s[nt][i + 1]}; const f32x2 c2 = {LOG2E, LOG2E}, nb2 = {nb, nb};
        x = x * c2 + nb2;
        f32x2 pv; pv.x = __builtin_amdgcn_exp2f(x.x); pv.y = __builtin_amdgcn_exp2f(x.y);
        s[nt][i] = pv.x; s[nt][i + 1] = pv.y; ps2 += pv;
      }
    if (MODE != 2) l += ps2.x + ps2.y;
    if (MODE != 0) {
#pragma unroll
      for (int nt = 0; nt < 2; ++nt)
#pragma unroll
        for (int k2 = 0; k2 < 2; ++k2) {
          u32x4 pw;
#pragma unroll
          for (int e = 0; e < 4; ++e) pw[e] = cvt_pk_bf16(s[nt][8 * k2 + 2 * e], s[nt][8 * k2 + 2 * e + 1]);
          const bf16x8 pf = __builtin_bit_cast(bf16x8, pw);
#pragma unroll
          for (int dt = 0; dt < 2; ++dt) {
            const u32x2 v0 = vfr[nt][k2][dt][0], v1 = vfr[nt][k2][dt][1];
            const u32x4 vw = (u32x4){v0.x, v0.y, v1.x, v1.y};
            O[dt] = __builtin_amdgcn_mfma_f32_32x32x16_bf16(__builtin_bit_cast(bf16x8, vw), pf, O[dt], 0, 0, 0);
          }
        }
    }
    if (MODE == 2) {
      float rc[2][4], Gv[2][4];
#pragma unroll
      for (int nt = 0; nt < 2; ++nt)
#pragma unroll
        for (int rr = 0; rr < 4; ++rr) { Gv[nt][rr] = (s[nt][4 * rr] + s[nt][4 * rr + 1]) + (s[nt][4 * rr + 2] + s[nt][4 * rr + 3]); rc[nt][rr] = __shfl_xor(s[nt][4 * rr + 3], 32); }
#pragma unroll
      for (int nt = 0; nt < 2; ++nt)
#pragma unroll
        for (int rr = 0; rr < 4; ++rr) {
          const float prev = rr > 0 ? rc[nt][rr > 0 ? rr - 1 : 0] : (nt > 0 ? rc[0][3] : carry);
          float val = Gv[nt][rr] + (hh ? rc[nt][rr] : prev);
          val = quadsum(val);
          if ((col & 3) == 0) imp_row[j * 16 + nt * 8 + rr * 2 + hh] = val;
        }
      carry = rc[1][3];
    }
    asm volatile("s_waitcnt lgkmcnt(0)" ::: "memory");
    if (j1 < 0) break;
    j = j1; j1 = j2; st = st == 2 ? 0 : st + 1;
  }
  __builtin_amdgcn_s_barrier(); asm volatile("" ::: "memory");
#undef A_ISSUE
#undef A_DMA
}

DEVI void attn_phase(const Params& p, char* lds) {
  float* imp = (float*)(lds + 49152);
  u64* wun = (u64*)(lds + 49152 + 8448);
  const u16* Q = (const u16*)(p.ws + OFF_Q); const u16* ZS = (const u16*)(p.ws + OFF_ZS); const float* G = (const float*)(p.ws + OFF_G);
  u16* Y = (u16*)(p.ws + OFF_Y);
  const int tid = threadIdx.x, wave = tid >> 6, lane = tid & 63, col = lane & 31, hh = lane >> 5;
  const int tok_l = wave * 8 + (col >> 2), head_l = col & 3;
  const int rpr = gridDim.x >> 5;
  float mb_cmp, mb_slc, mb_win;
  { float gq = fabsf(p.q_gain[lane]), g0_ = fabsf(p.k_gain[lane]), g1_ = fabsf(p.k_gain[64 + lane]), g2_ = fabsf(p.k_gain[128 + lane]);
#pragma unroll
    for (int o = 1; o < 64; o <<= 1) { gq = fmaxf(gq, __shfl_xor(gq, o)); g0_ = fmaxf(g0_, __shfl_xor(g0_, o)); g1_ = fmaxf(g1_, __shfl_xor(g1_, o)); g2_ = fmaxf(g2_, __shfl_xor(g2_, o)); }
    mb_cmp = 8.f * gq * g0_ * LOG2E; mb_slc = 8.f * gq * g1_ * LOG2E; mb_win = 8.f * gq * g2_ * LOG2E; }
  if (*(const unsigned*)(lds + 74240)) __builtin_amdgcn_s_sleep(40);
  for (int item = blockIdx.x; item < 4096; item += gridDim.x) {
    int rank = item >> 5; const int bg = item & 31;
    if ((gridDim.x & 31) == 0) { const int rnd = item / gridDim.x; if (rnd & 1) rank = rnd * rpr + (rpr - 1 - (rank - rnd * rpr)); }
    const int qb = 127 - rank, b = bg >> 2, g = bg & 3, q0 = qb * 32, t = q0 + tok_l, head = g * 4 + head_l;
    const size_t tokg = (size_t)b * SEQ + t;
    bf16x8 qf[4];
#pragma unroll
    for (int s = 0; s < 4; ++s) qf[s] = *(const bf16x8*)(Q + tokg * 1024 + head * 64 + s * 16 + hh * 8);
    for (int i = tid; i < 32 * 65; i += 256) imp[i] = 0.f;
    f32x16 O[2];
    f32x16 fin[2];
#pragma unroll
    for (int dt = 0; dt < 2; ++dt)
#pragma unroll
      for (int i = 0; i < 16; ++i) { O[dt][i] = 0.f; }
    const float g0 = G[tokg * 48 + 0 * 16 + head], g1 = G[tokg * 48 + 1 * 16 + head], g2 = G[tokg * 48 + 2 * 16 + head];
    {
      const u16* KC = (const u16*)(p.ws + OFF_KC) + (size_t)bg * 256 * 64; const u16* VC = (const u16*)(p.ws + OFF_VCT) + (size_t)bg * 64 * 256;
      const int ntile = ((q0 >> 4) >> 6) + 1; const u64 tmask = (ntile >= 64) ? ~0ull : ((1ull << ntile) - 1);
      const int nmax = t >= 31 ? ((t - 31) >> 4) : -1;
      float l = 0.f;
      attn_branch<0>(lds, tmask, KC, VC, 256, 0, nmax, ~0ull, qf, mb_cmp, l, O, 0.f, nullptr);
      l += __shfl_xor(l, 32);
      const float nbc = l > 0.f ? (-__log2f(l) - mb_cmp) : NEGINF;
      attn_branch<2>(lds, tmask, KC, VC, 256, 0, nmax, ~0ull, qf, mb_cmp, l, O, nbc, imp + tok_l * 65);
#pragma unroll
      for (int dt = 0; dt < 2; ++dt)
#pragma unroll
        for (int i = 0; i < 16; ++i) { fin[dt][i] = g0 * O[dt][i]; O[dt][i] = 0.f; }
    }
    __syncthreads();
    u64 mysel = 0, wu = 0;
#pragma unroll 1
    for (int tk = 0; tk < 8; ++tk) {
      const int tkn = q0 + wave * 8 + tk, jt = tkn >> 6, jj = lane;
      const bool valid = jj <= jt; const bool forced = (jj == 0) || (jj == jt) || (jj == jt - 1);
      const float sc = imp[(wave * 8 + tk) * 65 + jj] + (forced ? 1e4f : 0.f);
      const unsigned key = __float_as_uint(sc);
      const u64 vm = __ballot(valid);
      u64 mask = vm;
      if (__popcll(vm) > 16) {
        unsigned T = 0;
#pragma unroll 1
        for (int bb = 30; bb >= 0; --bb) { const unsigned cand = T | (1u << bb); if (__popcll(__ballot(key >= cand) & vm) >= 16) T = cand; }
        const u64 gt = __ballot(key > T) & vm, eq = __ballot(key == T) & vm;
        const int need = 16 - (int)__popcll(gt);
        const int rank = (int)__builtin_amdgcn_mbcnt_hi((unsigned)(eq >> 32), __builtin_amdgcn_mbcnt_lo((unsigned)eq, 0u));
        mask = gt | (__ballot(key == T && rank < need) & vm);
      }
      if ((col >> 2) == tk) mysel = mask;
      wu |= mask;
    }
    if (lane == 0) wun[wave] = wu;
    __syncthreads();
    const u64 un = wun[0] | wun[1] | wun[2] | wun[3];
    {
      const u16* KS = (const u16*)(p.ws + OFF_KS) + (size_t)bg * SEQ * 64; const u16* VS = (const u16*)(p.ws + OFF_VST) + (size_t)bg * 64 * SEQ;
      float l = 0.f;
      attn_branch<1>(lds, un, KS, VS, SEQ, 0, t, mysel, qf, mb_slc, l, O, 0.f, nullptr);
      l += __shfl_xor(l, 32); const float sc = l > 0.f ? g1 / l : 0.f;
#pragma unroll
      for (int dt = 0; dt < 2; ++dt)
#pragma unroll
        for (int i = 0; i < 16; ++i) { fin[dt][i] += sc * O[dt][i]; O[dt][i] = 0.f; }
    }
    {
      const u16* KW = (const u16*)(p.ws + OFF_KW) + (size_t)bg * SEQ * 64; const u16* VW = (const u16*)(p.ws + OFF_VWT) + (size_t)bg * 64 * SEQ;
      const int jlo = (q0 > 511 ? q0 - 511 : 0) >> 6, jhi = (q0 + 31) >> 6;
      const u64 hi_m = (jhi >= 63) ? ~0ull : ((1ull << (jhi + 1)) - 1); const u64 tmask = hi_m & ~((1ull << jlo) - 1);
      float l = 0.f;
      attn_branch<1>(lds, tmask, KW, VW, SEQ, t - 511, t, ~0ull, qf, mb_win, l, O, 0.f, nullptr);
      l += __shfl_xor(l, 32); const float sc = l > 0.f ? g2 / l : 0.f;
#pragma unroll
      for (int dt = 0; dt < 2; ++dt)
#pragma unroll
        for (int i = 0; i < 16; ++i) O[dt][i] = fin[dt][i] + sc * O[dt][i];
    }
#pragma unroll
    for (int dt = 0; dt < 2; ++dt)
#pragma unroll
      for (int rr = 0; rr < 4; ++rr) {
        const size_t o = tokg * 1024 + head * 64 + dt * 32 + rr * 8 + 4 * hh;
        const u32x2 z = *(const u32x2*)(ZS + o); u32x2 w;
        w.x = cvt_pk_bf16(O[dt][rr * 4 + 0] * bflo(z.x), O[dt][rr * 4 + 1] * bfhi(z.x)); w.y = cvt_pk_bf16(O[dt][rr * 4 + 2] * bflo(z.y), O[dt][rr * 4 + 3] * bfhi(z.y));
        *(u32x2*)(Y + o) = w;
      }
  }
}


#define XB_TMO      128
#define XB_XCNT(j)  (256  + 64 * (j))
#define XB_XSUB(j)  (1280 + 64 * (j))
#define XB_XGEN(j)  (2304 + 64 * (j))
#define XB_TOP      3328
#define XB_TOPGEN   3392
#define XCD_BAR_WORDS 3456
#define XB_SPIN_CAP (1u << 22)
#define LAS __attribute__((address_space(3)))
DEVI unsigned xb_ld(unsigned* p)              { return __hip_atomic_load(p, __ATOMIC_RELAXED, __HIP_MEMORY_SCOPE_AGENT); }
DEVI unsigned xb_add(unsigned* p, unsigned v) { return __hip_atomic_fetch_add(p, v, __ATOMIC_RELAXED, __HIP_MEMORY_SCOPE_AGENT); }
DEVI unsigned xb_xcc_id() { return (unsigned)__builtin_amdgcn_s_getreg((3 << 11) | 20) & 0xFu; }
#define XB_SPIN(cond, bar) do { unsigned _sp = 0; while (cond) { __builtin_amdgcn_s_sleep(1); \
    if ((++_sp & 255u) == 0u) { if (xb_ld(&(bar)[XB_TMO])) break; if (_sp > XB_SPIN_CAP) { atomicAdd(&(bar)[XB_TMO], 1u); break; } } } } while (0)
struct XcdBarrier { unsigned* bar; unsigned x; volatile LAS unsigned* st; };
DEVI XcdBarrier xcd_barrier_post(unsigned* bar, volatile LAS unsigned* st) {
  XcdBarrier b; b.bar = bar; b.x = xb_xcc_id(); b.st = st;
  if (threadIdx.x == 0) (void)xb_add(&bar[XB_XCNT(b.x)], 1u);
  return b;
}
DEVI void xcd_barrier_complete(unsigned* bar, unsigned x, unsigned& nloc, unsigned& nx) {
  const unsigned G = gridDim.x;
  unsigned sum, cnt, mine, sp = 0u;
  for (;;) {
    sum = 0u; cnt = 0u; mine = 0u;
#pragma unroll
    for (unsigned j = 0; j < 16; ++j) { const unsigned c = xb_ld(&bar[XB_XCNT(j)]); sum += c; cnt += (c > 0u) ? 1u : 0u; mine = (j == x) ? c : mine; }
    if (sum == G) break;
    __builtin_amdgcn_s_sleep(1);
    if ((++sp & 255u) == 0u) { if (xb_ld(&bar[XB_TMO])) break; if (sp > XB_SPIN_CAP) { atomicAdd(&bar[XB_TMO], 1u); break; } }
  }
  nloc = mine > 0u ? mine : 1u; nx = cnt > 0u ? cnt : 1u;
}
DEVI void xcd_barrier(const XcdBarrier& b) {
  asm volatile("s_waitcnt vmcnt(0)" ::: "memory");
  __syncthreads();
  if (threadIdx.x == 0) {
    unsigned* bar = b.bar;
    __builtin_amdgcn_s_waitcnt(0);
    unsigned nloc = b.st[0], nx = b.st[1];
    if (nloc == 0u) { xcd_barrier_complete(bar, b.x, nloc, nx); b.st[0] = nloc; b.st[1] = nx; }
    const unsigned old = xb_add(&bar[XB_XSUB(b.x)], 1u);
    const unsigned gen = old / nloc;
    if (old + 1u == (gen + 1u) * nloc) {
      __builtin_amdgcn_fence(__ATOMIC_RELEASE, "agent");
      asm volatile("s_waitcnt vmcnt(0)" ::: "memory");
      const unsigned og = xb_add(&bar[XB_TOP], 1u);
      const unsigned tg = og / nx;
      if (og + 1u == (tg + 1u) * nx) xb_add(&bar[XB_TOPGEN], 1u);
      else XB_SPIN(xb_ld(&bar[XB_TOPGEN]) == tg, bar);
      __builtin_amdgcn_fence(__ATOMIC_ACQUIRE, "agent");
      xb_add(&bar[XB_XGEN(b.x)], 1u);
      asm volatile("s_waitcnt vmcnt(0)" ::: "memory");
    } else {
      XB_SPIN(xb_ld(&bar[XB_XGEN(b.x)]) == gen, bar);
      __builtin_amdgcn_fence(__ATOMIC_ACQUIRE, "agent");
      asm volatile("s_waitcnt vmcnt(0)" ::: "memory");
    }
  }
  __syncthreads();
}
constexpr int NPHASE = 12;
#ifndef PHSEL
#define PHSEL 0xFFFu
#endif
#define PHON(n) if (!((PHSEL >> (n)) & 1u)) break;
__global__ void __launch_bounds__(256, 2) mega(Params p, int ph_lo, int ph_hi) {
  __shared__ __attribute__((aligned(16))) char lds[74304];
  char* ws = p.ws;
  __shared__ uint4 xb_words;
  if (threadIdx.x == 0) {
    xb_words = make_uint4(0u, 0u, 0u, 0u);
    const unsigned hw = (unsigned)__builtin_amdgcn_s_getreg(((8 - 1) << 11) | (8 << 6) | 4);
    const unsigned key = ((xcc_id_() & 7u) << 8) | (hw & 0xffu);
    *(unsigned*)(lds + 74240) = __hip_atomic_fetch_add((unsigned*)(ws + OFF_BAR) + 4096 + key, 1u, __ATOMIC_RELAXED, __HIP_MEMORY_SCOPE_AGENT) & 1u;
  }
  __syncthreads();
  XcdBarrier gb;
  if (ph_hi - ph_lo > 1) gb = xcd_barrier_post((unsigned*)(ws + OFF_BAR), (volatile LAS unsigned*)&xb_words); else { gb.bar = nullptr; gb.x = 0; gb.st = nullptr; }
  if (ph_lo < 0) cg::this_grid().sync();
  if (((PHSEL >> 0) & 1u) && ph_lo <= 0 && 0 < ph_hi) {
        cvt_job(lds, p.w_in, 1024, 4096, 4096, (u16*)(ws + WT_IN), 1024);
        cvt_job(lds, p.w1, 1024, 64, 64, (u16*)(ws + WT_L1), 1024);
        cvt_job(lds, p.a1, 1024, 64, 64, (u16*)(ws + WT_L1) + 192 * 1024, 1024);
        zero_job((u16*)(ws + WT_L1) + 64 * 1024, 128, 1024, 1024);
        cvt_job(lds, p.w2, 64, 1024, 1024, (u16*)(ws + WT_W2), 64);
        cvt_job(lds, p.a2, 64, 1024, 1024, (u16*)(ws + WT_A2), 64);
        cvt_job(lds, p.w_out, 1024, 1024, 1024, (u16*)(ws + WT_OUT), 1024);
        cvt_job(lds, p.n_w_in, 1024, 3632, 3712, (u16*)(ws + WT_NIN), 1024);
        cvt_job(lds, p.cmp_w1, 2048, 256, 256, (u16*)(ws + WT_C1), 2048);
        cvt_job(lds, p.cmp_w1 + 2048 * 256, 2048, 256, 256, (u16*)(ws + WT_C1) + 256 * 2048, 2048);
        cvt_job(lds, p.cmp_w2, 256, 64, 128, (u16*)(ws + WT_C2), 256);
        cvt_job(lds, p.cmp_w2 + 256 * 64, 256, 64, 128, (u16*)(ws + WT_C2) + 128 * 256, 256);
        cvt_job(lds, p.n_w_out, 1024, 1024, 1024, (u16*)(ws + WT_NOUT), 1024);
        rmsnorm_phase(p.x, p.norm_g, (u16*)(ws + OFF_H));
  }
  if (ph_lo <= 0 && 0 + 1 < ph_hi) xcd_barrier(gb);
  if (((PHSEL >> 1) & 1u) && ph_lo <= 1 && 1 < ph_hi) {
        gemm_run(lds, 256, 32, 1024, (const u16*)(ws + WT_IN), ALMix{(const u16*)(ws + OFF_H), p.mu, 0, 0},
                 EpiRwkvProj{(_Float16*)(ws + OFF_R), (_Float16*)(ws + OFF_K), (_Float16*)(ws + OFF_V), (_Float16*)(ws + OFF_Z)});
        gemm_run(lds, 256, 2, 1024, (const u16*)(ws + WT_L1), ALMix{(const u16*)(ws + OFF_H), p.mu, 1, 0}, EpiL1{(u16*)(ws + OFF_HID)});
  }
  if (ph_lo <= 1 && 1 + 1 < ph_hi) xcd_barrier(gb);
  if (((PHSEL >> 2) & 1u) && ph_lo <= 2 && 2 < ph_hi) {
        gemm_run(lds, 256, 8, 64, (const u16*)(ws + WT_W2), ALPlain{(const u16*)(ws + OFF_HID), 128}, EpiL2<0>{(_Float16*)p.out, p.w0});
        gemm_run(lds, 256, 8, 64, (const u16*)(ws + WT_A2), ALPlain{(const u16*)(ws + OFF_HID) + 64, 128}, EpiL2<1>{(_Float16*)p.out + (size_t)NT * 1024, p.a0});
  }
  if (ph_lo <= 2 && 2 + 1 < ph_hi) xcd_barrier(gb);
  if (((PHSEL >> 3) & 1u) && ph_lo <= 3 && 3 < ph_hi) { scan_phase(p, lds); }
  if (ph_lo <= 3 && 3 + 1 < ph_hi) xcd_barrier(gb);
  if (((PHSEL >> 4) & 1u) && ph_lo <= 4 && 4 < ph_hi) { post_phase(p); }
  if (ph_lo <= 4 && 4 + 1 < ph_hi) xcd_barrier(gb);
  if (((PHSEL >> 5) & 1u) && ph_lo <= 5 && 5 < ph_hi) { gemm_dma(lds, 128, 8, 1024, (const u16*)(ws + OFF_Y), 1024, (const u16*)(ws + WT_OUT), EpiResid{p.x, p.out}); }
  if (ph_lo <= 5 && 5 + 1 < ph_hi) xcd_barrier(gb);
  if (((PHSEL >> 6) & 1u) && ph_lo <= 6 && 6 < ph_hi) { rmsnorm_phase(p.out, p.norm_g + 1024, (u16*)(ws + OFF_H)); }
  if (ph_lo <= 6 && 6 + 1 < ph_hi) xcd_barrier(gb);
  if (((PHSEL >> 7) & 1u) && ph_lo <= 7 && 7 < ph_hi) {
    gemm_dma(lds, 128, 28, 1024, (const u16*)(ws + OFF_H), 1024, (const u16*)(ws + WT_NIN), EpiNsaIn{ws, p.q_gain, p.k_gain, 0});
    gemm_run(lds, 256, 1, 1024, (const u16*)(ws + WT_NIN) + (size_t)28 * 128 * 1024, ALPlain{(const u16*)(ws + OFF_H), 1024}, EpiNsaIn{ws, p.q_gain, p.k_gain, 28 * 128});
  }
  if (ph_lo <= 7 && 7 + 1 < ph_hi) xcd_barrier(gb);
  if (((PHSEL >> 8) & 1u) && ph_lo <= 8 && 8 < ph_hi) {
        gemm_run(lds, 64, 4, 2048, (const u16*)(ws + WT_C1), ALCmp{(const u16*)(ws + OFF_KCR), (const u16*)(ws + OFF_VCR), p.cmp_pe, nullptr, nullptr}, EpiCmp1{(u16*)(ws + OFF_HIDC), p.cmp_b1});
  }
  if (ph_lo <= 8 && 8 + 1 < ph_hi) xcd_barrier(gb);
  if (((PHSEL >> 9) & 1u) && ph_lo <= 9 && 9 < ph_hi) {
        for (int i = blockIdx.x * 256 + threadIdx.x; i < 32 * 64; i += gridDim.x * 256) { const int bg = i >> 6, d = i & 63; ((u16*)(ws + OFF_KC))[((size_t)bg * 256 + 255) * 64 + d] = 0; ((u16*)(ws + OFF_VCT))[((size_t)bg * 64 + d) * 256 + 255] = 0; }
        gemm_run(lds, 64, 1, 256, (const u16*)(ws + WT_C2), ALPlain{(const u16*)(ws + OFF_HIDC), 256}, EpiCmp2<0>{(u16*)(ws + OFF_KC), p.k_gain});
        gemm_run(lds, 64, 1, 256, (const u16*)(ws + WT_C2) + 128 * 256, ALPlain{(const u16*)(ws + OFF_HIDC) + 8192 * 256, 256}, EpiCmp2<1>{(u16*)(ws + OFF_VCT), nullptr});
  }
  if (ph_lo <= 9 && 9 + 1 < ph_hi) xcd_barrier(gb);
  if (((PHSEL >> 10) & 1u) && ph_lo <= 10 && 10 < ph_hi) { attn_phase(p, lds); }
  if (ph_lo <= 10 && 10 + 1 < ph_hi) xcd_barrier(gb);
  if (((PHSEL >> 11) & 1u) && ph_lo <= 11 && 11 < ph_hi) { gemm_dma(lds, 128, 8, 1024, (const u16*)(ws + OFF_Y), 1024, (const u16*)(ws + WT_NOUT), EpiResid{p.out, p.out}); }
  if (ph_lo <= 11 && 11 + 1 < ph_hi) xcd_barrier(gb);
}

extern "C" void kernel_launch(void* const* d_in, const int* in_sizes, int n_in, void* d_out, int out_size, void* d_ws, size_t ws_size, hipStream_t stream) {
  Params p{};
  const float** pp = (const float**)&p;
  for (int i = 0; i < 24; ++i) pp[i] = (const float*)d_in[i];
  p.out = (float*)d_out; p.ws = (char*)d_ws;
  static int grid_blocks = 0;
  if (!grid_blocks) {
    int dev = 0, cus = 0, per_cu = 0;
    hipGetDevice(&dev);
    hipDeviceGetAttribute(&cus, hipDeviceAttributeMultiprocessorCount, dev);
    hipOccupancyMaxActiveBlocksPerMultiprocessor(&per_cu, mega, 256, 0);
    if (per_cu > 2) per_cu = 2;
    if (per_cu < 1) per_cu = 1;
    grid_blocks = cus * per_cu;
  }
#if MULTI_LAUNCH
  for (int ph = 0; ph < NPHASE; ++ph) {
    hipLaunchKernelGGL(mega, dim3(grid_blocks), dim3(256), 0, stream, p, ph, ph + 1);
#ifdef DUP_MASK
    if ((DUP_MASK >> ph) & 1) hipLaunchKernelGGL(mega, dim3(grid_blocks), dim3(256), 0, stream, p, ph, ph + 1);
#endif
  }
#else
  hipMemsetAsync((char*)d_ws + OFF_BAR, 0, (4096 + 2048 + 64) * 4, stream);
  int lo = 0, hi = NPHASE;
  void* args[] = {&p, &lo, &hi};
  hipError_t e = hipLaunchCooperativeKernel((void*)mega, dim3(grid_blocks), dim3(256), args, 0, stream);
  if (e != hipSuccess) fprintf(stderr, "cooperative launch failed: %s (grid %d)\n", hipGetErrorString(e), grid_blocks);
#endif
}
```
